# Optimizing an MI355X kernel written in HIP

```python
import math
import jax
import jax.numpy as jnp
from jax import lax
import numpy as np

D_MODEL = 1024
BATCH = 2
SEQ = 8192
DEPTH = 2

N_EVEN = (DEPTH + 1) // 2
N_ODD = DEPTH // 2
Q_BLOCK = 128
EPS = 1e-6
SB_HEADS = 8
SB_HEAD_DIM = 64
SB_WIDTH = SB_HEADS * SB_HEAD_DIM
MLA_HEADS = 8
MLA_Q_RANK = 256
MLA_KV_RANK = 128
MLA_NOPE_DIM = 64
MLA_ROPE_DIM = 32
MLA_QK_DIM = MLA_NOPE_DIM + MLA_ROPE_DIM
MLA_V_DIM = 64
MLA_WIDTH = MLA_HEADS * MLA_V_DIM
ROPE_THETA = 10000.0
OFF_SB_K = SB_WIDTH
OFF_SB_V = 2 * SB_WIDTH
OFF_CQ = 3 * SB_WIDTH
OFF_CKV = OFF_CQ + MLA_Q_RANK
OFF_KR = OFF_CKV + MLA_KV_RANK
IN_COLS = OFF_KR + MLA_ROPE_DIM
MIX_WIDTH = SB_WIDTH + MLA_WIDTH
SSM_WIDTH = D_MODEL // 2
SSM_GROUP = 16
SSM_GROUPS = SSM_WIDTH // SSM_GROUP
SSM_STATE = 64
DT_MIN = 1e-3
DT_MAX = 1e-1
EIG_RE_MAX = -1e-4
D_FF = 7 * D_MODEL // 2
N_EXPERTS = 8
TOP_K = 2
EXPERT_BLOCK = 128

kernel_name = 'hybrid_stickbreak_mla_s5_moe'


def _rms_norm(x, gain):
    xf = x.astype(jnp.float32)
    y = xf * lax.rsqrt(jnp.mean(xf * xf, axis=-1, keepdims=True) + EPS)
    return (y * gain.astype(jnp.float32)).astype(x.dtype)


def _to_heads(t, heads):
    b, s, _ = t.shape
    return t.reshape(b, s, heads, -1).transpose(0, 2, 1, 3).astype(jnp.float32)


def _from_heads(t):
    b, h, s, d = t.shape
    return t.transpose(0, 2, 1, 3).reshape(b, s, h * d)


def _sweep_query_blocks(block_fn, q, k, v):
    b, h, s, dq = q.shape
    nb = s // Q_BLOCK
    qb = q.reshape(b, h, nb, Q_BLOCK, dq).transpose(2, 0, 1, 3, 4)
    starts = jnp.arange(nb, dtype=jnp.int32) * Q_BLOCK
    out = lax.map(lambda args: block_fn(args[0], args[1], k, v), (qb, starts))
    return out.transpose(1, 2, 0, 3, 4).reshape(b, h, s, v.shape[-1])


def _stick_breaking_block(q_blk, t0, k, v):
    s_len = k.shape[2]
    t_idx = t0 + jnp.arange(Q_BLOCK, dtype=jnp.int32)
    s_idx = jnp.arange(s_len, dtype=jnp.int32)
    earlier = s_idx[None, :] < t_idx[:, None]
    z = jnp.einsum('bhqd,bhkd->bhqk', q_blk, k) * (q_blk.shape[-1] ** -0.5)
    log_fail = jnp.where(earlier, jax.nn.log_sigmoid(-z), 0.0)
    log_stick = lax.cumsum(log_fail, axis=3, reverse=True) - log_fail
    w = jnp.where(earlier, jnp.exp(jax.nn.log_sigmoid(z) + log_stick), 0.0)
    return jnp.einsum('bhqk,bhkd->bhqd', w, v)


def _causal_softmax_block(q_blk, t0, k, v):
    s_len = k.shape[2]
    t_idx = t0 + jnp.arange(Q_BLOCK, dtype=jnp.int32)
    s_idx = jnp.arange(s_len, dtype=jnp.int32)
    visible = s_idx[None, :] <= t_idx[:, None]
    z = jnp.einsum('bhqd,bhkd->bhqk', q_blk, k) * (q_blk.shape[-1] ** -0.5)
    p = jax.nn.softmax(jnp.where(visible, z, -jnp.inf), axis=-1)
    return jnp.einsum('bhqk,bhkd->bhqd', p, v)


def _rope_tables(s_len):
    inv_freq = ROPE_THETA ** (-jnp.arange(0, MLA_ROPE_DIM, 2, dtype=jnp.float32) / MLA_ROPE_DIM)
    ang = jnp.arange(s_len, dtype=jnp.float32)[:, None] * inv_freq[None, :]
    return jnp.cos(ang), jnp.sin(ang)


def _rope_tail(t, cos, sin):
    half = MLA_ROPE_DIM // 2
    nope = t[..., :MLA_NOPE_DIM]
    r1 = t[..., MLA_NOPE_DIM:MLA_NOPE_DIM + half]
    r2 = t[..., MLA_NOPE_DIM + half:]
    c = cos[None, :, None, :]
    s = sin[None, :, None, :]
    return jnp.concatenate([nope, r1 * c - r2 * s, r2 * c + r1 * s], axis=-1)


def _attention_layer(x, norm_g, w_in, q_lat_g, w_q_up, kv_lat_g, w_kv_up, q_g, k_g, w_out):
    b, s, _ = x.shape
    h = _rms_norm(x, norm_g) @ w_in
    o_sb = _sweep_query_blocks(
        _stick_breaking_block,
        _to_heads(h[..., :OFF_SB_K], SB_HEADS),
        _to_heads(h[..., OFF_SB_K:OFF_SB_V], SB_HEADS),
        _to_heads(h[..., OFF_SB_V:OFF_CQ], SB_HEADS))
    c_q = _rms_norm(h[..., OFF_CQ:OFF_CKV], q_lat_g)
    c_kv = _rms_norm(h[..., OFF_CKV:OFF_KR], kv_lat_g)
    k_rope = h[..., OFF_KR:]
    q = (c_q @ w_q_up).reshape(b, s, MLA_HEADS, MLA_QK_DIM)
    kv = (c_kv @ w_kv_up).reshape(b, s, MLA_HEADS, MLA_NOPE_DIM + MLA_V_DIM)
    k = jnp.concatenate(
        [kv[..., :MLA_NOPE_DIM],
         jnp.broadcast_to(k_rope[:, :, None, :], (b, s, MLA_HEADS, MLA_ROPE_DIM))], axis=-1)
    v = kv[..., MLA_NOPE_DIM:].astype(jnp.float32)
    q = _rms_norm(q, q_g).astype(jnp.float32)
    k = _rms_norm(k, k_g).astype(jnp.float32)
    cos, sin = _rope_tables(s)
    q = _rope_tail(q, cos, sin)
    k = _rope_tail(k, cos, sin)
    o_mla = _sweep_query_blocks(
        _causal_softmax_block,
        q.transpose(0, 2, 1, 3), k.transpose(0, 2, 1, 3), v.transpose(0, 2, 1, 3))
    merged = jnp.concatenate([_from_heads(o_sb), _from_heads(o_mla)], axis=-1)
    return x + merged.astype(x.dtype) @ w_out


def _dense_swiglu_layer(x, norm_g, w_gate, w_up, w_down):
    xn = _rms_norm(x, norm_g)
    return x + (jax.nn.silu(xn @ w_gate) * (xn @ w_up)) @ w_down


def _s5_discretize(a_re, a_im, log_dt, b_re, b_im):
    a_re = jnp.minimum(a_re.astype(jnp.float32), EIG_RE_MAX)
    a_im = a_im.astype(jnp.float32)
    dt = jnp.exp(log_dt.astype(jnp.float32))[:, None]
    mag = jnp.exp(a_re * dt)
    lam_re = mag * jnp.cos(a_im * dt)
    lam_im = mag * jnp.sin(a_im * dt)
    den = a_re * a_re + a_im * a_im
    num_re = lam_re - 1.0
    coef_re = ((num_re * a_re + lam_im * a_im) / den)[..., None]
    coef_im = ((lam_im * a_re - num_re * a_im) / den)[..., None]
    b_re = b_re.astype(jnp.float32)
    b_im = b_im.astype(jnp.float32)
    bb_re = coef_re * b_re - coef_im * b_im
    bb_im = coef_re * b_im + coef_im * b_re
    return lam_re, lam_im, bb_re, bb_im


def _complex_affine_combine(first, second):
    a1r, a1i, b1r, b1i = first
    a2r, a2i, b2r, b2i = second
    return (a2r * a1r - a2i * a1i,
            a2r * a1i + a2i * a1r,
            a2r * b1r - a2i * b1i + b2r,
            a2r * b1i + a2i * b1r + b2i)


def _s5_layer(x, norm_g, w_in, a_re, a_im, log_dt, b_re, b_im, c_re, c_im, d_skip, w_glu):
    b, s, _ = x.shape
    u = (_rms_norm(x, norm_g) @ w_in).astype(jnp.float32)
    lam_re, lam_im, bb_re, bb_im = _s5_discretize(a_re, a_im, log_dt, b_re, b_im)
    ug = u.reshape(b, s, SSM_GROUPS, SSM_GROUP)
    bu_re = jnp.einsum('bsgc,gnc->bsgn', ug, bb_re)
    bu_im = jnp.einsum('bsgc,gnc->bsgn', ug, bb_im)
    full = bu_re.shape
    _, _, h_re, h_im = lax.associative_scan(
        _complex_affine_combine,
        (jnp.broadcast_to(lam_re, full), jnp.broadcast_to(lam_im, full), bu_re, bu_im),
        axis=1)
    y = (jnp.einsum('bsgn,gcn->bsgc', h_re, c_re.astype(jnp.float32))
         - jnp.einsum('bsgn,gcn->bsgc', h_im, c_im.astype(jnp.float32))).reshape(b, s, SSM_WIDTH)
    y = jax.nn.gelu(y + d_skip.astype(jnp.float32) * u).astype(x.dtype)
    z = y @ w_glu
    return x + z[..., :D_MODEL] * jax.nn.sigmoid(z[..., D_MODEL:])


def _moe_swiglu_layer(x, norm_g, w_router, w_gate, w_up, w_down):
    b, s, d = x.shape
    xt = _rms_norm(x, norm_g).reshape(-1, d)
    n_tok = xt.shape[0]
    logits = xt.astype(jnp.float32) @ w_router.astype(jnp.float32)
    top_vals, top_idx = lax.top_k(logits, TOP_K)
    gates = jax.nn.softmax(top_vals, axis=-1)
    n_assign = n_tok * TOP_K
    flat_e = top_idx.reshape(-1).astype(jnp.int32)
    flat_tok = jnp.repeat(jnp.arange(n_tok, dtype=jnp.int32), TOP_K)
    flat_w = gates.reshape(-1)
    order = jnp.argsort(flat_e)
    e_sorted = flat_e[order]
    counts = jnp.bincount(flat_e, length=N_EXPERTS).astype(jnp.int32)
    padded = (counts + EXPERT_BLOCK - 1) // EXPERT_BLOCK * EXPERT_BLOCK
    pad_end = jnp.cumsum(padded)
    pad_start = pad_end - padded
    unpad_start = jnp.cumsum(counts) - counts
    dest = pad_start[e_sorted] + jnp.arange(n_assign, dtype=jnp.int32) - unpad_start[e_sorted]
    n_slots = (n_assign + EXPERT_BLOCK - 1) // EXPERT_BLOCK * EXPERT_BLOCK + N_EXPERTS * EXPERT_BLOCK
    n_blocks = n_slots // EXPERT_BLOCK
    slot_tok = jnp.zeros((n_slots,), jnp.int32).at[dest].set(flat_tok[order])
    slot_w = jnp.zeros((n_slots,), jnp.float32).at[dest].set(flat_w[order])
    blk_start = jnp.arange(n_blocks, dtype=jnp.int32) * EXPERT_BLOCK
    blk_expert = jnp.clip(jnp.searchsorted(pad_end, blk_start, side='right'), 0, N_EXPERTS - 1)
    xs = xt[slot_tok].reshape(n_blocks, EXPERT_BLOCK, d)

    def expert_block(args):
        xb, e = args
        return (jax.nn.silu(xb @ w_gate[e]) * (xb @ w_up[e])) @ w_down[e]

    ys = lax.map(expert_block, (xs, blk_expert)).reshape(n_slots, d)
    out = jax.ops.segment_sum(ys.astype(jnp.float32) * slot_w[:, None], slot_tok, num_segments=n_tok)
    return x + out.reshape(b, s, d).astype(x.dtype)


def setup_inputs(seed: int = 0) -> dict:
    key = jax.random.key(seed)
    ks = jax.random.split(key, 30)
    f32 = jnp.float32

    def nrm(k, shape, scale):
        return jax.random.normal(k, shape, f32) * scale

    def gain(k, shape):
        return 1.0 + 0.02 * jax.random.normal(k, shape, f32)

    ne, no = N_EVEN, N_ODD
    return {
        'x': jax.random.normal(ks[0], (BATCH, SEQ, D_MODEL), f32),
        'att_norm': gain(ks[1], (ne, D_MODEL)),
        'att_w_in': nrm(ks[2], (ne, D_MODEL, IN_COLS), D_MODEL ** -0.5),
        'att_q_latent_norm': gain(ks[3], (ne, MLA_Q_RANK)),
        'att_w_q_up': nrm(ks[4], (ne, MLA_Q_RANK, MLA_HEADS * MLA_QK_DIM), MLA_Q_RANK ** -0.5),
        'att_kv_latent_norm': gain(ks[5], (ne, MLA_KV_RANK)),
        'att_w_kv_up': nrm(ks[6], (ne, MLA_KV_RANK, MLA_HEADS * (MLA_NOPE_DIM + MLA_V_DIM)), MLA_KV_RANK ** -0.5),
        'att_q_norm': gain(ks[7], (ne, MLA_QK_DIM)),
        'att_k_norm': gain(ks[8], (ne, MLA_QK_DIM)),
        'att_w_out': nrm(ks[9], (ne, MIX_WIDTH, D_MODEL), MIX_WIDTH ** -0.5),
        'dffn_norm': gain(ks[10], (ne, D_MODEL)),
        'dffn_w_gate': nrm(ks[11], (ne, D_MODEL, D_FF), D_MODEL ** -0.5),
        'dffn_w_up': nrm(ks[12], (ne, D_MODEL, D_FF), D_MODEL ** -0.5),
        'dffn_w_down': nrm(ks[13], (ne, D_FF, D_MODEL), D_FF ** -0.5),
        'ssm_norm': gain(ks[14], (no, D_MODEL)),
        'ssm_w_in': nrm(ks[15], (no, D_MODEL, SSM_WIDTH), D_MODEL ** -0.5),
        'ssm_a_re': -0.5 + nrm(ks[16], (no, SSM_GROUPS, SSM_STATE), 0.01),
        'ssm_a_im': math.pi * jnp.arange(SSM_STATE, dtype=f32)[None, None, :]
                    + nrm(ks[17], (no, SSM_GROUPS, SSM_STATE), 0.01),
        'ssm_log_dt': jax.random.uniform(ks[18], (no, SSM_GROUPS), f32,
                                         minval=math.log(DT_MIN), maxval=math.log(DT_MAX)),
        'ssm_b_re': nrm(ks[19], (no, SSM_GROUPS, SSM_STATE, SSM_GROUP), (2 * SSM_GROUP) ** -0.5),
        'ssm_b_im': nrm(ks[20], (no, SSM_GROUPS, SSM_STATE, SSM_GROUP), (2 * SSM_GROUP) ** -0.5),
        'ssm_c_re': nrm(ks[21], (no, SSM_GROUPS, SSM_GROUP, SSM_STATE), 0.5),
        'ssm_c_im': nrm(ks[22], (no, SSM_GROUPS, SSM_GROUP, SSM_STATE), 0.5),
        'ssm_d': nrm(ks[23], (no, SSM_WIDTH), 1.0),
        'ssm_w_glu': nrm(ks[24], (no, SSM_WIDTH, 2 * D_MODEL), SSM_WIDTH ** -0.5),
        'moe_norm': gain(ks[25], (no, D_MODEL)),
        'moe_router': nrm(ks[26], (no, D_MODEL, N_EXPERTS), D_MODEL ** -0.5),
        'moe_w_gate': nrm(ks[27], (no, N_EXPERTS, D_MODEL, D_FF), D_MODEL ** -0.5),
        'moe_w_up': nrm(ks[28], (no, N_EXPERTS, D_MODEL, D_FF), D_MODEL ** -0.5),
        'moe_w_down': nrm(ks[29], (no, N_EXPERTS, D_FF, D_MODEL), D_FF ** -0.5),
    }


def reference(x, att_norm, att_w_in, att_q_latent_norm, att_w_q_up, att_kv_latent_norm, att_w_kv_up,
              att_q_norm, att_k_norm, att_w_out, dffn_norm, dffn_w_gate, dffn_w_up, dffn_w_down,
              ssm_norm, ssm_w_in, ssm_a_re, ssm_a_im, ssm_log_dt, ssm_b_re, ssm_b_im, ssm_c_re, ssm_c_im,
              ssm_d, ssm_w_glu, moe_norm, moe_router, moe_w_gate, moe_w_up, moe_w_down):
    h = x
    for layer in range(DEPTH):
        i = layer // 2
        if layer % 2 == 0:
            h = _attention_layer(h, att_norm[i], att_w_in[i], att_q_latent_norm[i], att_w_q_up[i],
                                 att_kv_latent_norm[i], att_w_kv_up[i], att_q_norm[i], att_k_norm[i],
                                 att_w_out[i])
            h = _dense_swiglu_layer(h, dffn_norm[i], dffn_w_gate[i], dffn_w_up[i], dffn_w_down[i])
        else:
            h = _s5_layer(h, ssm_norm[i], ssm_w_in[i], ssm_a_re[i], ssm_a_im[i], ssm_log_dt[i],
                          ssm_b_re[i], ssm_b_im[i], ssm_c_re[i], ssm_c_im[i], ssm_d[i], ssm_w_glu[i])
            h = _moe_swiglu_layer(h, moe_norm[i], moe_router[i], moe_w_gate[i], moe_w_up[i], moe_w_down[i])
    return h
```

```cpp
#include <hip/hip_runtime.h>
#include <cstdio>
#include <cstdint>
#include <cmath>
namespace pg8 {
#define PG8_LAS __attribute__((address_space(3)))
typedef unsigned short bf16_t;
typedef short bf16x8 __attribute__((ext_vector_type(8)));
typedef float f32x4 __attribute__((ext_vector_type(4)));
typedef unsigned u32x4 __attribute__((ext_vector_type(4)));
constexpr int BM = 256, BK = 64, HALF = 128, HTB = HALF * BK * 2  , STAGE_BYTES = 8 * HTB, NXCD = 8, WGM = 8;

__host__ __device__ __forceinline__ int lds_byte(int r, int c) { const int st = (r >> 4) * 2 + (c >> 5), rr = r & 15, cc = c & 31, ob = rr * 64 + cc * 2; return st * 1024 + (ob ^ (((ob >> 9) & 1) << 5)); }
__host__ __device__ __forceinline__ void stage_rc(int b, int& R, int& C) { const int st = b / 1024, sb = b % 1024, swz = sb ^ (((sb >> 9) & 1) << 5); R = (st >> 1) * 16 + swz / 64; C = (st & 1) * 32 + (swz % 64) / 2; }
__host__ __device__ __forceinline__ int perm32(int rho) { const int n = rho >> 4, i = rho & 15; return 8 * (i >> 2) + 4 * n + (i & 3); }

struct Unit { int pm, pn; };
struct Gemm { const bf16_t* A; const bf16_t* Bt; int M, N, K; };

struct StaticOrder {
    int nM, nN, nwg, G, c;
    __host__ __device__ void init(int M, int N, int G_, int c_) { nM = M / BM; nN = N / BM; nwg = nM * nN; G = G_; c = c_; }
    __host__ __device__ bool next(int i, Unit& u) const {
        const long L = (long)i * G + c; if (L >= nwg) return false;
        int wgid = (int)L; { const int q = nwg / NXCD, r = nwg % NXCD, xcd = wgid % NXCD, off = wgid / NXCD; wgid = (xcd < r ? xcd * (q + 1) : r * (q + 1) + (xcd - r) * q) + off; }
        const int nig = WGM * nN, gid = wgid / nig, fm = gid * WGM, gsz = (nM - fm) < WGM ? (nM - fm) : WGM;
        u.pm = fm + ((wgid % nig) % gsz); u.pn = (wgid % nig) / gsz; return true;
    }
    __device__ __forceinline__ void a_ready(const Unit&) const {}
    __device__ __forceinline__ void done(const Unit&) const {}
};

__device__ __forceinline__ unsigned cvt_pk_bf16(float lo, float hi) { unsigned r; asm volatile("v_cvt_pk_bf16_f32 %0, %1, %2" : "=v"(r) : "v"(lo), "v"(hi)); return r; }
typedef float f32x2 __attribute__((ext_vector_type(2)));
typedef float f32x2 __attribute__((ext_vector_type(2)));
__device__ __forceinline__ float fast_sigmoid(float x) { return __builtin_amdgcn_rcpf(1.0f + __expf(-x)); }
struct EpiBf16Plain {
    static constexpr bool PERM = true, AFTER_DRAIN = false;
    bf16_t* O; int ldc;
    __device__ __forceinline__ void operator()(const f32x4 (&acc)[2][2][4][2], const Unit& u, int wr, int wc, int fr, int fq) const {
        const int row0 = u.pm * BM + wr * 64 + fr, col0 = u.pn * BM + wc * 32 + 8 * fq;
#pragma unroll
        for (int ai = 0; ai < 2; ++ai)
#pragma unroll
            for (int m = 0; m < 4; ++m) { bf16_t* rowp = O + (size_t)(row0 + ai * HALF + m * 16) * ldc + col0;
#pragma unroll
                for (int bj = 0; bj < 2; ++bj) { const f32x4 v0 = acc[ai][bj][m][0], v1 = acc[ai][bj][m][1];
                    u32x4 w; w.x = cvt_pk_bf16(v0[0], v0[1]); w.y = cvt_pk_bf16(v0[2], v0[3]); w.z = cvt_pk_bf16(v1[0], v1[1]); w.w = cvt_pk_bf16(v1[2], v1[3]);
                    *(u32x4*)(rowp + bj * HALF) = w; } }
    }
};
struct EpiResF32 {
    static constexpr bool PERM = false, AFTER_DRAIN = false;
    const float* base; float* out; int ldc;
    __device__ __forceinline__ void operator()(const f32x4 (&acc)[2][2][4][2], const Unit& u, int wr, int wc, int fr, int fq) const {
        const int col0 = u.pn * BM + wc * 32 + 4 * fq;
#pragma unroll
        for (int ai = 0; ai < 2; ++ai)
#pragma unroll
            for (int m = 0; m < 4; ++m) { const int r = ai * HALF + wr * 64 + m * 16 + fr; const size_t off = (size_t)(u.pm * BM + r) * ldc + col0;
#pragma unroll
                for (int bj = 0; bj < 2; ++bj)
#pragma unroll
                    for (int n = 0; n < 2; ++n) { const size_t o = off + bj * HALF + n * 16; f32x4 v = acc[ai][bj][m][n]; if (base) v = v + *(const f32x4*)(base + o); *(f32x4*)(out + o) = v; } }
    }
};
struct EpiSwiGLU {
    static constexpr bool PERM = true, AFTER_DRAIN = false;
    bf16_t* O; int ldc, ngrp, sub;
    __device__ __forceinline__ void operator()(const f32x4 (&acc)[2][2][4][2], const Unit& u, int wr, int wc, int fr, int fq) const {
        const int ct = (u.pn % ngrp) - sub; const int row0 = u.pm * BM + wr * 64 + fr, col0 = ct * HALF + wc * 32 + 8 * fq;
#pragma unroll
        for (int ai = 0; ai < 2; ++ai)
#pragma unroll
            for (int m = 0; m < 4; ++m) { bf16_t* rowp = O + (size_t)(row0 + ai * HALF + m * 16) * ldc + col0;
                f32x4 a[2];
#pragma unroll
                for (int n = 0; n < 2; ++n) { const f32x4 g = acc[ai][0][m][n], up = acc[ai][1][m][n];
#pragma unroll
                    for (int j = 0; j < 4; ++j) a[n][j] = g[j] * fast_sigmoid(g[j]) * up[j]; }
                u32x4 w; w.x = cvt_pk_bf16(a[0][0], a[0][1]); w.y = cvt_pk_bf16(a[0][2], a[0][3]); w.z = cvt_pk_bf16(a[1][0], a[1][1]); w.w = cvt_pk_bf16(a[1][2], a[1][3]);
                *(u32x4*)rowp = w; }
    }
};
struct EpiGLU {
    static constexpr bool PERM = false, AFTER_DRAIN = false;
    float* out; int ldc;
    __device__ __forceinline__ void operator()(const f32x4 (&acc)[2][2][4][2], const Unit& u, int wr, int wc, int fr, int fq) const {
        const int col0 = u.pn * HALF + wc * 32 + 4 * fq;
#pragma unroll
        for (int ai = 0; ai < 2; ++ai)
#pragma unroll
            for (int m = 0; m < 4; ++m) { const int r = ai * HALF + wr * 64 + m * 16 + fr; const size_t off = (size_t)(u.pm * BM + r) * ldc + col0;
#pragma unroll
                for (int n = 0; n < 2; ++n) { const size_t o = off + n * 16; const f32x4 a = acc[ai][0][m][n], g = acc[ai][1][m][n]; f32x4 v = *(const f32x4*)(out + o);
#pragma unroll
                    for (int j = 0; j < 4; ++j) v[j] += a[j] * fast_sigmoid(g[j]);
                    *(f32x4*)(out + o) = v; } }
    }
};
struct EpiMoeDown {
    static constexpr bool PERM = false, AFTER_DRAIN = false;
    float* out; const int* slot_tok; const float* slot_w;
    __device__ __forceinline__ void operator()(const f32x4 (&acc)[2][2][4][2], const Unit& u, int wr, int wc, int fr, int fq) const {
        const int colb = (u.pn & 3) * BM + wc * 32 + 4 * fq;
#pragma unroll
        for (int ai = 0; ai < 2; ++ai)
#pragma unroll
            for (int m = 0; m < 4; ++m) { const int s = u.pm * BM + ai * HALF + wr * 64 + m * 16 + fr; const int tok = slot_tok[s]; const float w = slot_w[s];
                if (tok >= 0) { float* orow = out + (size_t)tok * 1024 + colb;
#pragma unroll
                    for (int bj = 0; bj < 2; ++bj)
#pragma unroll
                        for (int n = 0; n < 2; ++n) { const f32x4 v = acc[ai][bj][m][n] * w; float* p = orow + bj * HALF + n * 16;
                            unsafeAtomicAdd(p + 0, v[0]); unsafeAtomicAdd(p + 1, v[1]); unsafeAtomicAdd(p + 2, v[2]); unsafeAtomicAdd(p + 3, v[3]); } } }
    }
};
struct MoeOrder {
    const int* tile_e; int nrt, ncol, mul, coloff, G, c;
    __device__ __forceinline__ bool next(int i, Unit& u) const {
        const int L = i * G + c; if (L >= nrt * ncol) return false;
        const int rt = L / ncol, jj = L - rt * ncol; const int e = __builtin_amdgcn_readfirstlane(tile_e[rt]);
        u.pm = rt; u.pn = e * mul + coloff + jj; return true;
    }
    __device__ __forceinline__ void a_ready(const Unit&) const {}
    __device__ __forceinline__ void done(const Unit&) const {}
};

template <class Epi, class Sched, bool ALIGN_EPI = false, bool SP2 = false>
__device__ __forceinline__ void gemm_phase(PG8_LAS unsigned char* lds, const Gemm g, const Sched& S, const Epi& E) {
    const int tid = threadIdx.x, wid = __builtin_amdgcn_readfirstlane(tid >> 6), lane = tid & 63, wr = wid >> 2, wc = wid & 3, fr = lane & 15, fq = lane >> 4;
    const int K = g.K, nt = K / BK;
    unsigned voffA[2], voffB[2];
#pragma unroll
    for (int i = 0; i < 2; ++i) { int R, C; stage_rc(tid * 16 + i * 8192, R, C); const int Rb = Epi::PERM ? ((R & ~31) + perm32(R & 31)) : R;
        voffA[i] = (unsigned)(R * K + C) * 2u; voffB[i] = (unsigned)(Rb * K + C) * 2u; }
    const size_t kstep = (size_t)(BK * 2);
    const size_t hstep = (size_t)HALF * K * 2;
    const size_t tstep = 2 * hstep;
    const unsigned ldsw = (unsigned)wid * 1024u;
    const int aoff = lds_byte(wr * 64 + fr, fq * 8), boff = lds_byte(wc * 32 + fr, fq * 8);
#define PG8_SA(b, h) (((b) * 2 + (h)) * HTB)
#define PG8_SB(b, h) ((4 + (b) * 2 + (h)) * HTB)
#define PG8_STAGE(bufoff, gbase, voff) do { _Pragma("unroll") for (int _i = 0; _i < 2; ++_i) \
        __builtin_amdgcn_global_load_lds((const unsigned*)((const char*)(gbase) + (voff)[_i]), (PG8_LAS unsigned*)(lds + (bufoff) + ldsw + _i * 8192), 16, 0, 0); } while (0)
#define PG8_LDA(dst, b, h) do { _Pragma("unroll") for (int m = 0; m < 4; ++m) _Pragma("unroll") for (int k = 0; k < 2; ++k) dst[m][k] = *(const PG8_LAS bf16x8*)(lds + PG8_SA(b, h) + aoff + m * 2048 + k * 1024); } while (0)
#define PG8_LDB(dst, b, h) do { _Pragma("unroll") for (int n = 0; n < 2; ++n) _Pragma("unroll") for (int k = 0; k < 2; ++k) dst[n][k] = *(const PG8_LAS bf16x8*)(lds + PG8_SB(b, h) + boff + n * 2048 + k * 1024); } while (0)
#define PG8_MMA(ai, bj, At, Bt) do { __builtin_amdgcn_s_setprio(1); _Pragma("unroll") for (int m = 0; m < 4; ++m) _Pragma("unroll") for (int n = 0; n < 2; ++n) _Pragma("unroll") for (int k = 0; k < 2; ++k) \
        acc[ai][bj][m][n] = __builtin_amdgcn_mfma_f32_16x16x32_bf16(Bt[n][k], At[m][k], acc[ai][bj][m][n], 0, 0, 0); __builtin_amdgcn_s_setprio(0); } while (0)
#define PG8_WAIT_V(n) asm volatile("s_waitcnt vmcnt(" #n ")" ::: "memory")
#define PG8_WAIT_L(n) asm volatile("s_waitcnt lgkmcnt(" #n ")" ::: "memory")
#define PG8_BAR __builtin_amdgcn_s_barrier()
#define PG8_SCHED __builtin_amdgcn_sched_barrier(0)
    Unit cur, nxt; int ui = 0;
    if (!S.next(0, cur)) return;
    f32x4 acc[2][2][4][2];
#pragma unroll
    for (int a = 0; a < 2; ++a)
#pragma unroll
        for (int b = 0; b < 2; ++b)
#pragma unroll
            for (int m = 0; m < 4; ++m)
#pragma unroll
                for (int n = 0; n < 2; ++n) acc[a][b][m][n] = (f32x4){0.f, 0.f, 0.f, 0.f};
    bf16x8 At[4][2], B0[2][2], B1[2][2];
    const char* cA = (const char*)g.A + (size_t)cur.pm * tstep; const char* cB = (const char*)g.Bt + (size_t)cur.pn * tstep;
    S.a_ready(cur);
    if constexpr (SP2) {
        PG8_STAGE(PG8_SB(0, 0), cB, voffB); PG8_STAGE(PG8_SB(0, 1), cB + hstep, voffB); PG8_STAGE(PG8_SA(0, 0), cA, voffA); PG8_STAGE(PG8_SA(0, 1), cA + hstep, voffA);
        if (wr == 1) PG8_BAR;
        PG8_WAIT_V(2); PG8_BAR;
        PG8_STAGE(PG8_SB(1, 0), cB + kstep, voffB); PG8_STAGE(PG8_SA(1, 0), cA + kstep, voffA); PG8_STAGE(PG8_SB(1, 1), cB + hstep + kstep, voffB);
        PG8_WAIT_V(6); PG8_BAR;
    } else {
        PG8_STAGE(PG8_SB(0, 0), cB, voffB); PG8_STAGE(PG8_SA(0, 0), cA, voffA); PG8_STAGE(PG8_SB(0, 1), cB + hstep, voffB); PG8_STAGE(PG8_SA(0, 1), cA + hstep, voffA);
        if (wr == 1) PG8_BAR;
        PG8_WAIT_V(4); PG8_BAR;
        PG8_STAGE(PG8_SB(1, 0), cB + kstep, voffB); PG8_STAGE(PG8_SA(1, 0), cA + kstep, voffA); PG8_STAGE(PG8_SB(1, 1), cB + hstep + kstep, voffB);
        PG8_WAIT_V(6); PG8_BAR;
    }
    for (;;) {
        const bool has_next = S.next(ui + 1, nxt);
        const char* nA = has_next ? (const char*)g.A + (size_t)nxt.pm * tstep : cA; const char* nB = has_next ? (const char*)g.Bt + (size_t)nxt.pn * tstep : cB;
        for (int t = 0; t < nt; t += 2) {
            const bool last = (t == nt - 2);
            const char* a1 = cA + (size_t)(t + 1) * kstep;
            const char* a2 = last ? nA : cA + (size_t)(t + 2) * kstep; const char* b2 = last ? nB : cB + (size_t)(t + 2) * kstep;
            const char* a3 = a2 + kstep; const char* b3 = b2 + kstep;
            if (last && has_next) S.a_ready(nxt);
            if constexpr (SP2) {
            PG8_LDB(B0, 0, 0); PG8_LDB(B1, 0, 1); PG8_SCHED; PG8_LDA(At, 0, 0); PG8_STAGE(PG8_SA(1, 1), a1 + hstep, voffA);
            PG8_WAIT_V(8); PG8_WAIT_L(0); PG8_BAR; PG8_MMA(0, 0, At, B0); PG8_MMA(0, 1, At, B1); PG8_BAR; PG8_SCHED;
            PG8_LDA(At, 0, 1); PG8_STAGE(PG8_SB(0, 0), b2, voffB); PG8_STAGE(PG8_SB(0, 1), b2 + hstep, voffB); PG8_STAGE(PG8_SA(0, 0), a2, voffA);
            PG8_WAIT_V(8); PG8_WAIT_L(0); PG8_BAR; PG8_MMA(1, 0, At, B0); PG8_MMA(1, 1, At, B1); PG8_BAR; PG8_SCHED;
            PG8_LDB(B0, 1, 0); PG8_LDB(B1, 1, 1); PG8_SCHED; PG8_LDA(At, 1, 0); PG8_STAGE(PG8_SA(0, 1), a2 + hstep, voffA);
            PG8_WAIT_V(8); PG8_WAIT_L(0); PG8_BAR; PG8_MMA(0, 0, At, B0); PG8_MMA(0, 1, At, B1); PG8_BAR; PG8_SCHED;
            PG8_LDA(At, 1, 1); PG8_STAGE(PG8_SB(1, 0), b3, voffB); PG8_STAGE(PG8_SB(1, 1), b3 + hstep, voffB); PG8_STAGE(PG8_SA(1, 0), a3, voffA);
            PG8_WAIT_V(8); PG8_WAIT_L(0); PG8_BAR; PG8_MMA(1, 0, At, B0); PG8_MMA(1, 1, At, B1); PG8_BAR; PG8_SCHED;
            } else {
            PG8_LDB(B0, 0, 0); PG8_SCHED; PG8_LDA(At, 0, 0); PG8_STAGE(PG8_SA(1, 1), a1 + hstep, voffA);
            PG8_WAIT_L(8); PG8_BAR; PG8_WAIT_L(0); PG8_MMA(0, 0, At, B0); PG8_BAR; PG8_SCHED;
            PG8_LDB(B1, 0, 1); PG8_STAGE(PG8_SB(0, 0), b2, voffB);
            PG8_BAR; PG8_WAIT_L(0); PG8_MMA(0, 1, At, B1); PG8_BAR;
            PG8_LDA(At, 0, 1); PG8_STAGE(PG8_SA(0, 0), a2, voffA);
            PG8_BAR; PG8_WAIT_L(0); PG8_MMA(1, 0, At, B0); PG8_BAR; PG8_SCHED;
            PG8_STAGE(PG8_SB(0, 1), b2 + hstep, voffB);
            PG8_WAIT_V(6); PG8_BAR; PG8_MMA(1, 1, At, B1); PG8_BAR;
            PG8_LDB(B0, 1, 0); PG8_SCHED; PG8_LDA(At, 1, 0); PG8_STAGE(PG8_SA(0, 1), a2 + hstep, voffA);
            PG8_WAIT_L(8); PG8_BAR; PG8_WAIT_L(0); PG8_MMA(0, 0, At, B0); PG8_BAR; PG8_SCHED;
            PG8_LDB(B1, 1, 1); PG8_STAGE(PG8_SB(1, 0), b3, voffB);
            PG8_BAR; PG8_WAIT_L(0); PG8_MMA(0, 1, At, B1); PG8_BAR;
            PG8_LDA(At, 1, 1); PG8_STAGE(PG8_SA(1, 0), a3, voffA);
            PG8_BAR; PG8_WAIT_L(0); PG8_MMA(1, 0, At, B0); PG8_BAR; PG8_SCHED;
            PG8_STAGE(PG8_SB(1, 1), b3 + hstep, voffB);
            PG8_WAIT_V(6); PG8_BAR; PG8_MMA(1, 1, At, B1); PG8_BAR;
            }
        }
        if constexpr (ALIGN_EPI) { if (wr == 0) PG8_BAR; }
        if constexpr (!Epi::AFTER_DRAIN) { E(acc, cur, wr, wc, fr, fq); S.done(cur); }
        if (!has_next) break;
#pragma unroll
        for (int a = 0; a < 2; ++a)
#pragma unroll
            for (int b = 0; b < 2; ++b)
#pragma unroll
                for (int m = 0; m < 4; ++m)
#pragma unroll
                    for (int n = 0; n < 2; ++n) acc[a][b][m][n] = (f32x4){0.f, 0.f, 0.f, 0.f};
        cur = nxt; cA = nA; cB = nB; ++ui;
        if constexpr (ALIGN_EPI) { if (wr == 1) PG8_BAR; }
    }
    PG8_WAIT_V(0);
    if constexpr (!ALIGN_EPI) { if (wr == 0) PG8_BAR; }
    PG8_BAR;
    if constexpr (Epi::AFTER_DRAIN) { E.fused(acc, cur, wr, wc, fr, fq, lds, wid, lane); S.done(cur); }
#undef PG8_SA
#undef PG8_SB
#undef PG8_STAGE
#undef PG8_LDA
#undef PG8_LDB
#undef PG8_MMA
#undef PG8_WAIT_V
#undef PG8_WAIT_L
#undef PG8_BAR
#undef PG8_SCHED
}
}
#define LAS __attribute__((address_space(3)))
#define XB_TMO      128
#define XB_XCNT(j)  (256  + 64 * (j))
#define XB_XSUB(j)  (1280 + 64 * (j))
#define XB_XGEN(j)  (2304 + 64 * (j))
#define XB_TOP      3328
#define XB_TOPGEN   3392
#define XCD_BAR_WORDS 3456
#define XB_SPIN_CAP (1u << 18)

__device__ __forceinline__ unsigned xb_ld(unsigned* p)              { return __hip_atomic_load(p, __ATOMIC_RELAXED, __HIP_MEMORY_SCOPE_AGENT); }
__device__ __forceinline__ unsigned xb_add(unsigned* p, unsigned v) { return __hip_atomic_fetch_add(p, v, __ATOMIC_RELAXED, __HIP_MEMORY_SCOPE_AGENT); }
__device__ __forceinline__ unsigned xb_xcc_id() { return (unsigned)__builtin_amdgcn_s_getreg((3 << 11) | 20) & 0xFu; }
#define XB_SPIN(cond, bar) do { unsigned _sp = 0; while (cond) { __builtin_amdgcn_s_sleep(1); \
    if ((++_sp & 255u) == 0u) { if (xb_ld(&(bar)[XB_TMO])) break; if (_sp > XB_SPIN_CAP) { atomicAdd(&(bar)[XB_TMO], 1u); break; } } } } while (0)

struct XcdBarrier {
    unsigned* bar; unsigned x;
    volatile LAS unsigned* st;
};

__device__ __forceinline__ XcdBarrier xcd_barrier_post(unsigned* bar, volatile LAS unsigned* st) {
    XcdBarrier b; b.bar = bar; b.x = xb_xcc_id(); b.st = st;
    if (threadIdx.x == 0) (void)xb_add(&bar[XB_XCNT(b.x)], 1u);
    return b;
}
__device__ __forceinline__ void xcd_barrier_complete(unsigned* bar, unsigned x, unsigned& nloc, unsigned& nx) {
    const unsigned G = gridDim.x * gridDim.y * gridDim.z;
    unsigned sum, cnt, mine, sp = 0u;
    for (;;) {
        sum = 0u; cnt = 0u; mine = 0u;
#pragma unroll
        for (unsigned j = 0; j < 16; ++j) { const unsigned c = xb_ld(&bar[XB_XCNT(j)]); sum += c; cnt += (c > 0u) ? 1u : 0u; mine = (j == x) ? c : mine; }
        if (sum == G) break;
        __builtin_amdgcn_s_sleep(1);
        if ((++sp & 255u) == 0u) { if (xb_ld(&bar[XB_TMO])) break; if (sp > XB_SPIN_CAP) { atomicAdd(&bar[XB_TMO], 1u); break; } }
    }
    nloc = mine > 0u ? mine : 1u; nx = cnt > 0u ? cnt : 1u;
}

__device__ __forceinline__ void xcd_barrier(const XcdBarrier& b) {
    asm volatile("s_waitcnt vmcnt(0)" ::: "memory");
    __syncthreads();
    if (threadIdx.x == 0) {
        unsigned* bar = b.bar;
        __builtin_amdgcn_s_waitcnt(0);
        unsigned nloc = b.st[0], nx = b.st[1];
        if (nloc == 0u) { xcd_barrier_complete(bar, b.x, nloc, nx); b.st[0] = nloc; b.st[1] = nx; }
        const unsigned old = xb_add(&bar[XB_XSUB(b.x)], 1u);
        const unsigned gen = old / nloc;
        if (old + 1u == (gen + 1u) * nloc) {
            __builtin_amdgcn_fence(__ATOMIC_RELEASE, "agent");
            asm volatile("s_waitcnt vmcnt(0)" ::: "memory");
            const unsigned og = xb_add(&bar[XB_TOP], 1u);
            const unsigned tg = og / nx;
            if (og + 1u == (tg + 1u) * nx) xb_add(&bar[XB_TOPGEN], 1u);
            else XB_SPIN(xb_ld(&bar[XB_TOPGEN]) == tg, bar);
            __builtin_amdgcn_fence(__ATOMIC_ACQUIRE, "agent");
            xb_add(&bar[XB_XGEN(b.x)], 1u);
            asm volatile("s_waitcnt vmcnt(0)" ::: "memory");
        } else {
            XB_SPIN(xb_ld(&bar[XB_XGEN(b.x)]) == gen, bar);
            __builtin_amdgcn_fence(__ATOMIC_ACQUIRE, "agent");
            asm volatile("s_waitcnt vmcnt(0)" ::: "memory");
        }
    }
    __syncthreads();
}
#define GAS __attribute__((address_space(1)))
typedef unsigned short bf16;
typedef unsigned v4u __attribute__((ext_vector_type(4)));
typedef unsigned v2u __attribute__((ext_vector_type(2)));
typedef float f32x4 __attribute__((ext_vector_type(4)));
typedef float f32x16 __attribute__((ext_vector_type(16)));
typedef float f32x2 __attribute__((ext_vector_type(2)));
typedef short bf16x8 __attribute__((ext_vector_type(8)));
typedef GAS unsigned gu32;
#define RLX_AGENT __ATOMIC_RELAXED, __HIP_MEMORY_SCOPE_AGENT
#define LDS_WAIT() asm volatile("s_waitcnt lgkmcnt(0)" ::: "memory")
#define VM_WAIT() asm volatile("s_waitcnt vmcnt(0)" ::: "memory")
__device__ __forceinline__ unsigned f2bf(float f) { unsigned u = __builtin_bit_cast(unsigned, f); return (u + 0x7fffu + ((u >> 16) & 1u)) >> 16; }
__device__ __forceinline__ unsigned pk2(float lo, float hi) { return f2bf(lo) | (f2bf(hi) << 16); }
__device__ __forceinline__ float bflo(unsigned u) { return __uint_as_float(u << 16); }
__device__ __forceinline__ float bfhi(unsigned u) { return __uint_as_float(u & 0xffff0000u); }

constexpr int NWAVES = 8;
constexpr int SEQ = 8192, NB = 2, M = NB * SEQ, D = 1024;
constexpr int INC = 1952, INP = 2048;
constexpr int FF = 3584, NE = 8;
constexpr int SW = 512;
constexpr int CH = 128, NCH = SEQ / CH;
constexpr int FFH = FF / 2;
constexpr int MAXSLOT = 2 * M + NE * 256;
constexpr float EPS = 1e-6f;
constexpr size_t MiB = 1u << 20;
constexpr size_t WS_CTL = 0, CTL_ZERO_BYTES = 1 * MiB;
constexpr size_t WS_WIN = 1 * MiB;
constexpr size_t WS_WQUP = 5 * MiB;
constexpr size_t WS_WKVUP = 5 * MiB + 512 * 1024;
constexpr size_t WS_WOUT = 6 * MiB;
constexpr size_t WS_WDGU = 8 * MiB;
constexpr size_t WS_WDDN = 22 * MiB;
constexpr size_t WS_WSIN = 29 * MiB;
constexpr size_t WS_WGLU = 30 * MiB;
constexpr size_t WS_MGU = 32 * MiB;
constexpr size_t WS_MDN = 144 * MiB;
constexpr size_t WS_XN = 200 * MiB;
constexpr size_t WS_H = 32 * MiB;
constexpr size_t WS_QRAW = 96 * MiB;
constexpr size_t WS_KVRAW = 120 * MiB;
constexpr size_t WS_QM = 152 * MiB;
constexpr size_t WS_KM = 176 * MiB;
constexpr size_t WS_MERGED = 232 * MiB;
constexpr size_t WS_CQ = 264 * MiB;
constexpr size_t WS_CKV = 272 * MiB;
constexpr size_t WS_DACT = 32 * MiB;
constexpr size_t WS_U = 232 * MiB;
constexpr size_t WS_HEND = 264 * MiB;
constexpr size_t WS_Y = 266 * MiB;
constexpr size_t WS_XS = 232 * MiB;
constexpr size_t WS_MACT = 300 * MiB;
constexpr size_t WS_LTOK = 420 * MiB;
constexpr size_t WS_LW = 421 * MiB;
constexpr size_t WS_STOK = 422 * MiB;
constexpr size_t WS_SW = 423 * MiB;
constexpr size_t WS_TILEE = 424 * MiB;
constexpr size_t WS_ROPE = 458 * MiB;
constexpr size_t WS_STAB = 459 * MiB;
constexpr size_t WS_END = 460 * MiB;
static_assert(WS_XS + (size_t)MAXSLOT * 1024 * 2 <= WS_MACT && WS_MACT + (size_t)MAXSLOT * FFH * 2 <= WS_LTOK, "moe map");
constexpr int CW_BAR = 4096;
constexpr int CW_QUEUE = 8192;
constexpr int CW_CNT = 8192 + 64;
constexpr int RING_OFF = 0, RING_BYTES = 131072;
constexpr int LDSCTL_OFF = RING_BYTES, MISC_OFF = LDSCTL_OFF + 320;
constexpr int LDS_BYTES = 147456;

__device__ __forceinline__ float wave_sum(float v) {
#pragma unroll
    for (int o = 1; o < 64; o <<= 1) v += __shfl_xor(v, o);
    return v;
}
__device__ __forceinline__ float wave_max(float v) {
#pragma unroll
    for (int o = 1; o < 64; o <<= 1) v = fmaxf(v, __shfl_xor(v, o));
    return v;
}

__device__ __forceinline__ void transpose_item(const float* __restrict__ W, int N, int k0, int n0, bf16* dst, int dpitch, LAS float* scr, int lane) {
#pragma unroll 8
    for (int i = 0; i < 32; ++i) { const int kk = 2 * i + (lane >> 5); scr[kk * 33 + (lane & 31)] = W[(size_t)(k0 + kk) * N + n0 + (lane & 31)]; }
    LDS_WAIT(); asm volatile("" ::: "memory");
    const int c = lane & 7;
#pragma unroll
    for (int j = 0; j < 4; ++j) { const int n = (lane >> 3) + 8 * j; const LAS float* s = scr + (8 * c) * 33 + n;
        v4u o; o.x = pk2(s[0 * 33], s[1 * 33]); o.y = pk2(s[2 * 33], s[3 * 33]); o.z = pk2(s[4 * 33], s[5 * 33]); o.w = pk2(s[6 * 33], s[7 * 33]);
        *(GAS v4u*)(dst + (size_t)n * dpitch + 8 * c) = o; }
    LDS_WAIT(); asm volatile("" ::: "memory");
}
__device__ __forceinline__ void rms_row_to_bf16(const float* xrow, const float* __restrict__ gain, bf16* orow, int lane) {
    const f32x4* xr = (const f32x4*)xrow + lane; const f32x4* gr = (const f32x4*)gain + lane;
    f32x4 v[4]; float s = 0.f;
#pragma unroll
    for (int j = 0; j < 4; ++j) { v[j] = xr[64 * j]; s += (v[j].x * v[j].x + v[j].y * v[j].y) + (v[j].z * v[j].z + v[j].w * v[j].w); }
    const float rstd = 1.0f / sqrtf(wave_sum(s) * (1.f / D) + EPS);
    unsigned long long* o8 = (unsigned long long*)orow + lane;
#pragma unroll
    for (int j = 0; j < 4; ++j) { const f32x4 g = gr[64 * j];
        o8[64 * j] = (unsigned long long)pk2(v[j].x * rstd * g.x, v[j].y * rstd * g.y) | ((unsigned long long)pk2(v[j].z * rstd * g.z, v[j].w * rstd * g.w) << 32); }
}

__device__ __forceinline__ float gelu_tanh(float x) {
    const float a = 0.7978845608028654f * (x + 0.044715f * x * x * x);
    const float t = 1.0f - 2.0f * __builtin_amdgcn_rcpf(1.0f + __expf(2.0f * a));
    return 0.5f * x * (1.0f + t);
}

__device__ __forceinline__ int crow(int r, int hi) { return (r & 3) + 8 * (r >> 2) + 4 * hi; }
template <int DQK, bool SB>
__device__ __forceinline__ void attn_unit(LAS unsigned char* lds, const bf16* Qp, int qpitch, const bf16* Kp, int kpitch, const bf16* Vp, int vpitch, bf16* Op, int opitch, int qb, int tid, int wid, int lane) {
    constexpr int KROW = (DQK + 8) * 2, KS_OFF = 0, VT_OFF = 64 * KROW, VROW = 144, FLAG_OFF = VT_OFF + 64 * VROW, NKS = DQK / 16, KCH = DQK / 8;
    const int r32 = lane & 31, hi = lane >> 5;
    const int qrow0 = qb * 256 + wid * 32;
    bf16x8 qr[NKS];
#pragma unroll
    for (int ks = 0; ks < NKS; ++ks) qr[ks] = *(const bf16x8*)(Qp + (size_t)(qrow0 + r32) * qpitch + ks * 16 + hi * 8);
    f32x16 o0, o1;
#pragma unroll
    for (int r = 0; r < 16; ++r) { o0[r] = 0.f; o1[r] = 0.f; }
    float m_run = -INFINITY, l_run = 0.f, A = 0.f;
    const int ntiles = 4 * qb + 4;
    LAS int* flags = (LAS int*)(lds + FLAG_OFF);
    if (SB) { if (tid < 8) flags[tid] = 0; }
    const int qglob = qrow0 + r32;
    for (int it = 0; it < ntiles; ++it) {
        const int j = SB ? (ntiles - 1 - it) : it;
        const int kv0 = j * 64;
        __syncthreads();
        if (SB) { bool alldead = true;
#pragma unroll
            for (int w = 0; w < 8; ++w) alldead = alldead && (flags[w] != 0);
            if (alldead) break; }
        for (int c = tid; c < 64 * KCH; c += NWAVES * 64) { const int row = c / KCH, ch = c - row * KCH;
            const v4u v = *(const v4u*)(Kp + (size_t)(kv0 + row) * kpitch + ch * 8); *(LAS v4u*)(lds + KS_OFF + row * KROW + ch * 16) = v; }
        { const int row = tid >> 3, ch = tid & 7; const v4u v = *(const v4u*)(Vp + (size_t)(kv0 + row) * vpitch + ch * 8);
            LAS unsigned short* vt = (LAS unsigned short*)(lds + VT_OFF) + (ch * 8) * (VROW / 2) + row;
            vt[0 * (VROW / 2)] = (unsigned short)(v.x & 0xffffu); vt[1 * (VROW / 2)] = (unsigned short)(v.x >> 16);
            vt[2 * (VROW / 2)] = (unsigned short)(v.y & 0xffffu); vt[3 * (VROW / 2)] = (unsigned short)(v.y >> 16);
            vt[4 * (VROW / 2)] = (unsigned short)(v.z & 0xffffu); vt[5 * (VROW / 2)] = (unsigned short)(v.z >> 16);
            vt[6 * (VROW / 2)] = (unsigned short)(v.w & 0xffffu); vt[7 * (VROW / 2)] = (unsigned short)(v.w >> 16); }
        __syncthreads();
        if (kv0 > qrow0 + 31) continue;
        f32x16 p0, p1;
#pragma unroll
        for (int r = 0; r < 16; ++r) { p0[r] = 0.f; p1[r] = 0.f; }
#pragma unroll
        for (int ks = 0; ks < NKS; ++ks) {
            const bf16x8 a0 = *(const LAS bf16x8*)(lds + KS_OFF + r32 * KROW + ks * 32 + hi * 16);
            const bf16x8 a1 = *(const LAS bf16x8*)(lds + KS_OFF + (32 + r32) * KROW + ks * 32 + hi * 16);
            p0 = __builtin_amdgcn_mfma_f32_32x32x16_bf16(a0, qr[ks], p0, 0, 0, 0);
            p1 = __builtin_amdgcn_mfma_f32_32x32x16_bf16(a1, qr[ks], p1, 0, 0, 0);
        }
        const bool diag = (kv0 + 63 >= qrow0);
        if (!SB) {
            if (diag) {
#pragma unroll
                for (int r = 0; r < 16; ++r) { const int kv = kv0 + crow(r, hi); if (kv > qglob) p0[r] = -INFINITY; if (kv + 32 > qglob) p1[r] = -INFINITY; }
            }
            float rm = fmaxf(p0[0], p1[0]);
#pragma unroll
            for (int r = 1; r < 16; ++r) rm = fmaxf(rm, fmaxf(p0[r], p1[r]));
            rm = fmaxf(rm, __shfl_xor(rm, 32));
            const float m_new = fmaxf(m_run, rm);
            const float f = __builtin_amdgcn_exp2f(m_run - m_new);
            m_run = m_new;
            float rs = 0.f;
#pragma unroll
            for (int r = 0; r < 16; ++r) { p0[r] = __builtin_amdgcn_exp2f(p0[r] - m_new); p1[r] = __builtin_amdgcn_exp2f(p1[r] - m_new); rs += p0[r] + p1[r]; }
            l_run = l_run * f + rs;
#pragma unroll
            for (int r = 0; r < 16; ++r) { o0[r] *= f; o1[r] *= f; }
        } else {
            f32x16 L0, L1;
#pragma unroll
            for (int r = 0; r < 16; ++r) {
                const float z0 = p0[r] * 0.125f, z1 = p1[r] * 0.125f;
                const float s0 = fmaxf(z0, 0.f) + __logf(1.0f + __expf(-fabsf(z0))), s1 = fmaxf(z1, 0.f) + __logf(1.0f + __expf(-fabsf(z1)));
                const int kv = kv0 + crow(r, hi);
                const bool v0 = !diag || (kv < qglob), v1 = !diag || (kv + 32 < qglob);
                p0[r] = v0 ? z0 : -INFINITY; p1[r] = v1 ? z1 : -INFINITY;
                L0[r] = v0 ? -s0 : 0.f; L1[r] = v1 ? -s1 : 0.f;
            }
            float gs[8], gp[8], tot[8], suf[8];
#pragma unroll
            for (int g = 0; g < 4; ++g) { gs[g] = (L0[4 * g] + L0[4 * g + 1]) + (L0[4 * g + 2] + L0[4 * g + 3]); gs[4 + g] = (L1[4 * g] + L1[4 * g + 1]) + (L1[4 * g + 2] + L1[4 * g + 3]); }
#pragma unroll
            for (int g = 0; g < 8; ++g) { gp[g] = __shfl_xor(gs[g], 32); tot[g] = gs[g] + gp[g]; }
            suf[7] = 0.f;
#pragma unroll
            for (int g = 6; g >= 0; --g) suf[g] = suf[g + 1] + tot[g + 1];
#pragma unroll
            for (int g = 0; g < 8; ++g) {
                const float E = suf[g] + (hi == 0 ? gp[g] : 0.f) + A;
                if (g < 4) { const float c3 = L0[4 * g + 3] + E, c2 = L0[4 * g + 2] + c3, c1 = L0[4 * g + 1] + c2, c0 = L0[4 * g] + c1;
                    p0[4 * g] = __expf(p0[4 * g] + c0); p0[4 * g + 1] = __expf(p0[4 * g + 1] + c1); p0[4 * g + 2] = __expf(p0[4 * g + 2] + c2); p0[4 * g + 3] = __expf(p0[4 * g + 3] + c3); }
                else { const int q = g - 4; const float c3 = L1[4 * q + 3] + E, c2 = L1[4 * q + 2] + c3, c1 = L1[4 * q + 1] + c2, c0 = L1[4 * q] + c1;
                    p1[4 * q] = __expf(p1[4 * q] + c0); p1[4 * q + 1] = __expf(p1[4 * q + 1] + c1); p1[4 * q + 2] = __expf(p1[4 * q + 2] + c2); p1[4 * q + 3] = __expf(p1[4 * q + 3] + c3); }
            }
            A = A + (suf[0] + tot[0]);
            const bool dead = __all(A < -104.0f);
            if (lane == 0) flags[wid] = dead ? 1 : 0;
        }
        bf16x8 pw[4];
        { v4u t;
          t.x = pk2(p0[0], p0[1]); t.y = pk2(p0[2], p0[3]); t.z = pk2(p0[4], p0[5]); t.w = pk2(p0[6], p0[7]); pw[0] = __builtin_bit_cast(bf16x8, t);
          t.x = pk2(p0[8], p0[9]); t.y = pk2(p0[10], p0[11]); t.z = pk2(p0[12], p0[13]); t.w = pk2(p0[14], p0[15]); pw[1] = __builtin_bit_cast(bf16x8, t);
          t.x = pk2(p1[0], p1[1]); t.y = pk2(p1[2], p1[3]); t.z = pk2(p1[4], p1[5]); t.w = pk2(p1[6], p1[7]); pw[2] = __builtin_bit_cast(bf16x8, t);
          t.x = pk2(p1[8], p1[9]); t.y = pk2(p1[10], p1[11]); t.z = pk2(p1[12], p1[13]); t.w = pk2(p1[14], p1[15]); pw[3] = __builtin_bit_cast(bf16x8, t); }
#pragma unroll
        for (int ks = 0; ks < 4; ++ks) {
            const LAS unsigned char* vb = lds + VT_OFF + (16 * ks + 4 * hi) * 2;
            const v2u a0l = *(const LAS v2u*)(vb + r32 * VROW), a0h = *(const LAS v2u*)(vb + r32 * VROW + 16);
            const v2u a1l = *(const LAS v2u*)(vb + (32 + r32) * VROW), a1h = *(const LAS v2u*)(vb + (32 + r32) * VROW + 16);
            const v4u a0 = {a0l.x, a0l.y, a0h.x, a0h.y}, a1 = {a1l.x, a1l.y, a1h.x, a1h.y};
            o0 = __builtin_amdgcn_mfma_f32_32x32x16_bf16(__builtin_bit_cast(bf16x8, a0), pw[ks], o0, 0, 0, 0);
            o1 = __builtin_amdgcn_mfma_f32_32x32x16_bf16(__builtin_bit_cast(bf16x8, a1), pw[ks], o1, 0, 0, 0);
        }
    }
    float inv = 1.0f;
    if (!SB) { const float lt = l_run + __shfl_xor(l_run, 32); inv = 1.0f / lt; }
    bf16* orow = Op + (size_t)(qrow0 + r32) * opitch;
#pragma unroll
    for (int g = 0; g < 4; ++g) {
        v2u w0, w1;
        w0.x = pk2(o0[4 * g] * inv, o0[4 * g + 1] * inv); w0.y = pk2(o0[4 * g + 2] * inv, o0[4 * g + 3] * inv);
        w1.x = pk2(o1[4 * g] * inv, o1[4 * g + 1] * inv); w1.y = pk2(o1[4 * g + 2] * inv, o1[4 * g + 3] * inv);
        *(v2u*)(orow + 8 * g + 4 * hi) = w0; *(v2u*)(orow + 32 + 8 * g + 4 * hi) = w1;
    }
    __syncthreads();
}
constexpr int NPH = 22;
#ifndef MK_PER_PHASE
#define MK_PER_PHASE 0
#endif
struct Args { const float* in[30]; float* out; unsigned char* ws; int ph_lo, ph_hi; };
__device__ const double kInvFreq4[4] = {1.0, 0.5623413251903491, 0.31622776601683794, 0.1778279410038923};

__global__ void __launch_bounds__(NWAVES * 64, 2) fwd(Args args) {
    extern __shared__ __attribute__((aligned(16))) unsigned char lds_raw[];
    LAS unsigned char* lds = (LAS unsigned char*)lds_raw;
    volatile LAS unsigned* MISC = (volatile LAS unsigned*)(lds + MISC_OFF);
    const int tid = threadIdx.x, lane = tid & 63, wave = __builtin_amdgcn_readfirstlane(tid >> 6);
    const int G = gridDim.x, bx = blockIdx.x;
    const int vcu = (G % 8 == 0) ? (bx % 8) * (G / 8) + bx / 8 : bx;
    const int gw = vcu * NWAVES + wave, NGW = G * NWAVES;
    unsigned char* ws = args.ws;
    gu32* ctl = (gu32*)(ws + WS_CTL);
    float* out = args.out;
    for (int u = tid; u < (LDS_BYTES - LDSCTL_OFF) / 4; u += NWAVES * 64) ((LAS unsigned*)(lds + LDSCTL_OFF))[u] = 0u;
    __syncthreads();
    XcdBarrier bar; bar.bar = (unsigned*)(ctl + CW_BAR); bar.x = 0; bar.st = nullptr;
    if (!MK_PER_PHASE) bar = xcd_barrier_post((unsigned*)(ctl + CW_BAR), MISC + 8);
#define GRID_BAR() do { if (!MK_PER_PHASE) xcd_barrier(bar); } while (0)
    const int lo = args.ph_lo, hi_ph = args.ph_hi;
#define IN(k) (lo <= (k) && (k) < hi_ph)
#define BOTH(k) (IN(k) && IN((k) + 1))

    bf16* Win_t = (bf16*)(ws + WS_WIN); bf16* Wqup_t = (bf16*)(ws + WS_WQUP); bf16* Wkvup_t = (bf16*)(ws + WS_WKVUP); bf16* Wout_t = (bf16*)(ws + WS_WOUT);
    bf16* Wdgu_t = (bf16*)(ws + WS_WDGU); bf16* Wddn_t = (bf16*)(ws + WS_WDDN); bf16* Wsin_t = (bf16*)(ws + WS_WSIN); bf16* Wglu_t = (bf16*)(ws + WS_WGLU);
    bf16* Mgu_t = (bf16*)(ws + WS_MGU); bf16* Mdn_t = (bf16*)(ws + WS_MDN);
    bf16* XN = (bf16*)(ws + WS_XN); bf16* Hb = (bf16*)(ws + WS_H); bf16* QRAW = (bf16*)(ws + WS_QRAW); bf16* KVRAW = (bf16*)(ws + WS_KVRAW);
    bf16* QM = (bf16*)(ws + WS_QM); bf16* KM = (bf16*)(ws + WS_KM); bf16* MERGED = (bf16*)(ws + WS_MERGED); bf16* CQ = (bf16*)(ws + WS_CQ); bf16* CKV = (bf16*)(ws + WS_CKV);
    bf16* DACT = (bf16*)(ws + WS_DACT); float* Ub = (float*)(ws + WS_U); float* HEND = (float*)(ws + WS_HEND); bf16* Yb = (bf16*)(ws + WS_Y);
    bf16* XS = (bf16*)(ws + WS_XS); bf16* MACT = (bf16*)(ws + WS_MACT); int* LTOK = (int*)(ws + WS_LTOK); float* LW = (float*)(ws + WS_LW);
    int* STOK = (int*)(ws + WS_STOK); float* SWT = (float*)(ws + WS_SW); int* TILEE = (int*)(ws + WS_TILEE);
    float* ROPE = (float*)(ws + WS_ROPE); float* STAB = (float*)(ws + WS_STAB);

    if (IN(0)) {
        LAS float* scr = (LAS float*)(lds + RING_OFF + wave * 16384);
        constexpr int I_IN = 16 * 61, I_QU = 4 * 24, I_KVU = 2 * 32, I_OUT = 16 * 32, I_DG = 16 * 112, I_DD = 56 * 32, I_SIN = 16 * 16, I_GLU = 8 * 64;
        constexpr int NIT = I_IN + I_QU + I_KVU + I_OUT + 2 * I_DG + I_DD + I_SIN + I_GLU;
        for (int it = gw; it < NIT; it += NGW) {
            int r = it;
            if (r < I_IN) { const int kb = r / 61, nb = r % 61; transpose_item(args.in[2], INC, 64 * kb, 32 * nb, Win_t + (size_t)(32 * nb) * 1024 + 64 * kb, 1024, scr, lane); continue; } r -= I_IN;
            if (r < I_QU) { const int kb = r / 24, nb = r % 24; transpose_item(args.in[4], 768, 64 * kb, 32 * nb, Wqup_t + (size_t)(32 * nb) * 256 + 64 * kb, 256, scr, lane); continue; } r -= I_QU;
            if (r < I_KVU) { const int kb = r / 32, nb = r % 32; transpose_item(args.in[6], 1024, 64 * kb, 32 * nb, Wkvup_t + (size_t)(32 * nb) * 128 + 64 * kb, 128, scr, lane); continue; } r -= I_KVU;
            if (r < I_OUT) { const int kb = r / 32, nb = r % 32; transpose_item(args.in[9], 1024, 64 * kb, 32 * nb, Wout_t + (size_t)(32 * nb) * 1024 + 64 * kb, 1024, scr, lane); continue; } r -= I_OUT;
            if (r < 2 * I_DG) { const int which = r / I_DG, rr = r % I_DG, kb = rr / 112, nb = rr % 112, n0 = 32 * nb; const int drow = 256 * (n0 / 128) + 128 * which + (n0 % 128);
                transpose_item(args.in[11 + which], FF, 64 * kb, n0, Wdgu_t + (size_t)drow * 1024 + 64 * kb, 1024, scr, lane); continue; } r -= 2 * I_DG;
            if (r < I_DD) { const int kb = r / 32, nb = r % 32; transpose_item(args.in[13], 1024, 64 * kb, 32 * nb, Wddn_t + (size_t)(32 * nb) * FF + 64 * kb, FF, scr, lane); continue; } r -= I_DD;
            if (r < I_SIN) { const int kb = r / 16, nb = r % 16; transpose_item(args.in[15], SW, 64 * kb, 32 * nb, Wsin_t + (size_t)(32 * nb) * 1024 + 64 * kb, 1024, scr, lane); continue; } r -= I_SIN;
            { const int kb = r / 64, nb = r % 64, n0 = 32 * nb; const int nn = n0 & 1023; const int drow = 256 * (nn / 128) + 128 * (n0 >> 10) + (nn % 128);
                transpose_item(args.in[24], 2048, 64 * kb, n0, Wglu_t + (size_t)drow * SW + 64 * kb, SW, scr, lane); }
        }
        for (int i = bx * (NWAVES * 64) + tid; i < 96 * 128; i += G * NWAVES * 64) ((v4u*)(Win_t + (size_t)INC * 1024))[i] = (v4u){0u, 0u, 0u, 0u};
        for (int i = bx * (NWAVES * 64) + tid; i < SEQ * 16; i += G * NWAVES * 64) {
            const int t = i >> 4, f = i & 15; double inv = kInvFreq4[f & 3]; const int dec = f >> 2; if (dec >= 1) inv *= 0.1; if (dec >= 2) inv *= 0.1; if (dec >= 3) inv *= 0.1;
            const double rev = (double)t * (double)(float)inv * 0.15915494309189535; const double fr = rev - __builtin_rint(rev);
            ROPE[2 * i] = __builtin_amdgcn_cosf((float)fr); ROPE[2 * i + 1] = __builtin_amdgcn_sinf((float)fr);
        }
        for (int i = bx * (NWAVES * 64) + tid; i < 32 * 64; i += G * NWAVES * 64) {
            const int g = i >> 6, n = i & 63;
            double are = (double)args.in[16][i]; if (are > -1e-4) are = -1e-4; const double aim = (double)args.in[17][i];
            const double dt = exp((double)args.in[18][g]);
            const double mag = exp(are * dt), lre = mag * cos(aim * dt), lim = mag * sin(aim * dt);
            const double den = are * are + aim * aim, nre = lre - 1.0;
            const double cre = (nre * are + lim * aim) / den, cim = (lim * are - nre * aim) / den;
            const double magL = exp(are * dt * CH), lLre = magL * cos(aim * dt * CH), lLim = magL * sin(aim * dt * CH);
            float* tb = STAB + (size_t)g * 36 * 64 + n;
            tb[0 * 64] = (float)lre; tb[1 * 64] = (float)lim; tb[2 * 64] = (float)lLre; tb[3 * 64] = (float)lLim;
            for (int c = 0; c < 16; ++c) { const double bre = (double)args.in[19][(size_t)i * 16 + c], bim = (double)args.in[20][(size_t)i * 16 + c];
                tb[(4 + c) * 64] = (float)(cre * bre - cim * bim); tb[(20 + c) * 64] = (float)(cre * bim + cim * bre); }
        }
        for (int m = gw; m < M; m += NGW) rms_row_to_bf16(args.in[0] + (size_t)m * D, args.in[1], XN + (size_t)m * D, lane);
        if (BOTH(0)) GRID_BAR();
    }
    if (IN(1)) {
        pg8::Gemm g{XN, Win_t, M, INP, D}; pg8::StaticOrder S; S.init(M, INP, G, bx);
        pg8::EpiBf16Plain E{Hb, INP};
        pg8::gemm_phase<pg8::EpiBf16Plain, pg8::StaticOrder, true, true>(lds + RING_OFF, g, S, E);
        if (BOTH(1)) GRID_BAR();
    }
    if (IN(2)) {
        const float* gq = args.in[3]; const float* gkv = args.in[5];
        for (int m = gw; m < M; m += NGW) {
            const bf16* hr = Hb + (size_t)m * INP;
            { const v2u raw = *(const v2u*)(hr + 1536 + 4 * lane); const float a = bflo(raw.x), b = bfhi(raw.x), c = bflo(raw.y), d = bfhi(raw.y);
              const float rstd = 1.0f / sqrtf(wave_sum((a * a + b * b) + (c * c + d * d)) * (1.f / 256.f) + EPS); const f32x4 gg = *(const f32x4*)(gq + 4 * lane);
              v2u o; o.x = pk2(a * rstd * gg.x, b * rstd * gg.y); o.y = pk2(c * rstd * gg.z, d * rstd * gg.w); *(v2u*)(CQ + (size_t)m * 256 + 4 * lane) = o; }
            { const unsigned raw = *(const unsigned*)(hr + 1792 + 2 * lane); const float a = bflo(raw), b = bfhi(raw);
              const float rstd = 1.0f / sqrtf(wave_sum(a * a + b * b) * (1.f / 128.f) + EPS);
              *(unsigned*)(CKV + (size_t)m * 128 + 2 * lane) = pk2(a * rstd * gkv[2 * lane], b * rstd * gkv[2 * lane + 1]); }
        }
        if (BOTH(2)) GRID_BAR();
    }
    if (IN(3)) {
        pg8::Gemm g{CQ, Wqup_t, M, 768, 256}; pg8::StaticOrder S; S.init(M, 768, G, bx);
        pg8::EpiBf16Plain E{QRAW, 768};
        pg8::gemm_phase<pg8::EpiBf16Plain, pg8::StaticOrder, true, true>(lds + RING_OFF, g, S, E);
        if (BOTH(3)) GRID_BAR();
    }
    if (IN(4)) {
        pg8::Gemm g{CKV, Wkvup_t, M, 1024, 128}; pg8::StaticOrder S; S.init(M, 1024, G, bx);
        pg8::EpiBf16Plain E{KVRAW, 1024};
        pg8::gemm_phase<pg8::EpiBf16Plain, pg8::StaticOrder, true, true>(lds + RING_OFF, g, S, E);
        if (BOTH(4)) GRID_BAR();
    }
    if (IN(5)) {
        const float* qg = args.in[7]; const float* kg = args.in[8];
        constexpr float QSCALE = 0.10206207261596575f * 1.4426950408889634f;
        for (int idx = bx * (NWAVES * 64) + tid; idx < M * 8; idx += G * NWAVES * 64) {
            const int m = idx >> 3, h = idx & 7, t = m & (SEQ - 1);
            const f32x4* rp = (const f32x4*)(ROPE + (size_t)t * 32);
            float cs[16], sn[16];
#pragma unroll
            for (int i = 0; i < 8; ++i) { const f32x4 v = rp[i]; cs[2 * i] = v.x; sn[2 * i] = v.y; cs[2 * i + 1] = v.z; sn[2 * i + 1] = v.w; }
#pragma unroll
            for (int which = 0; which < 2; ++which) {
                v4u ch[12];
                if (which == 0) {
                    const v4u* src = (const v4u*)(QRAW + (size_t)m * 768 + h * 96);
#pragma unroll
                    for (int c = 0; c < 12; ++c) ch[c] = src[c];
                } else {
                    const v4u* s1 = (const v4u*)(KVRAW + (size_t)m * 1024 + h * 128); const v4u* s2 = (const v4u*)(Hb + (size_t)m * INP + 1920);
#pragma unroll
                    for (int c = 0; c < 8; ++c) ch[c] = s1[c];
#pragma unroll
                    for (int c = 0; c < 4; ++c) ch[8 + c] = s2[c];
                }
                float ss = 0.f;
#pragma unroll
                for (int c = 0; c < 12; ++c) { const v4u v = ch[c]; const float a0 = bflo(v.x), a1 = bfhi(v.x), a2 = bflo(v.y), a3 = bfhi(v.y), a4 = bflo(v.z), a5 = bfhi(v.z), a6 = bflo(v.w), a7 = bfhi(v.w);
                    ss += ((a0 * a0 + a1 * a1) + (a2 * a2 + a3 * a3)) + ((a4 * a4 + a5 * a5) + (a6 * a6 + a7 * a7)); }
                const float rstd = 1.0f / sqrtf(ss * (1.f / 96.f) + EPS);
                const float osc = which == 0 ? QSCALE : 1.0f;
                const float* gn = which == 0 ? qg : kg;
                bf16* dst = (which == 0 ? QM : KM) + (size_t)m * 768 + h * 96;
#pragma unroll
                for (int c = 0; c < 8; ++c) { const v4u v = ch[c]; float a[8] = {bflo(v.x), bfhi(v.x), bflo(v.y), bfhi(v.y), bflo(v.z), bfhi(v.z), bflo(v.w), bfhi(v.w)};
#pragma unroll
                    for (int e = 0; e < 8; ++e) a[e] = a[e] * rstd * gn[8 * c + e] * osc;
                    v4u o; o.x = pk2(a[0], a[1]); o.y = pk2(a[2], a[3]); o.z = pk2(a[4], a[5]); o.w = pk2(a[6], a[7]); ((v4u*)dst)[c] = o; }
#pragma unroll
                for (int c = 0; c < 2; ++c) { const v4u v1 = ch[8 + c], v2 = ch[10 + c];
                    float a[8] = {bflo(v1.x), bfhi(v1.x), bflo(v1.y), bfhi(v1.y), bflo(v1.z), bfhi(v1.z), bflo(v1.w), bfhi(v1.w)};
                    float b[8] = {bflo(v2.x), bfhi(v2.x), bflo(v2.y), bfhi(v2.y), bflo(v2.z), bfhi(v2.z), bflo(v2.w), bfhi(v2.w)};
                    float ra[8], rb[8];
#pragma unroll
                    for (int e = 0; e < 8; ++e) { const float r1 = a[e] * rstd * gn[64 + 8 * c + e], r2 = b[e] * rstd * gn[80 + 8 * c + e]; const float co = cs[8 * c + e], si = sn[8 * c + e];
                        ra[e] = (r1 * co - r2 * si) * osc; rb[e] = (r2 * co + r1 * si) * osc; }
                    v4u o1, o2; o1.x = pk2(ra[0], ra[1]); o1.y = pk2(ra[2], ra[3]); o1.z = pk2(ra[4], ra[5]); o1.w = pk2(ra[6], ra[7]);
                    o2.x = pk2(rb[0], rb[1]); o2.y = pk2(rb[2], rb[3]); o2.z = pk2(rb[4], rb[5]); o2.w = pk2(rb[6], rb[7]);
                    ((v4u*)dst)[8 + c] = o1; ((v4u*)dst)[10 + c] = o2; }
            }
        }
        if (BOTH(5)) GRID_BAR();
    }
    if (IN(6)) {
        for (;;) {
            __syncthreads();
            if (tid == 0) MISC[0] = __hip_atomic_fetch_add(ctl + CW_QUEUE, 1u, RLX_AGENT);
            __syncthreads();
            const int idx = (int)MISC[0];
            if (idx >= 1024) break;
            const int qb = 31 - (idx >> 5), r = idx & 31, kind = r >> 4, bh = r & 15, b = bh >> 3, h = bh & 7;
            const size_t rb = (size_t)b * SEQ;
            if (kind == 0) attn_unit<96, false>(lds, QM + rb * 768 + h * 96, 768, KM + rb * 768 + h * 96, 768, KVRAW + rb * 1024 + h * 128 + 64, 1024, MERGED + rb * 1024 + 512 + h * 64, 1024, qb, tid, wave, lane);
            else attn_unit<64, true>(lds, Hb + rb * INP + h * 64, INP, Hb + rb * INP + 512 + h * 64, INP, Hb + rb * INP + 1024 + h * 64, INP, MERGED + rb * 1024 + h * 64, 1024, qb, tid, wave, lane);
        }
        if (BOTH(6)) GRID_BAR();
    }
    if (IN(7)) {
        pg8::Gemm g{MERGED, Wout_t, M, D, D}; pg8::StaticOrder S; S.init(M, D, G, bx);
        pg8::EpiResF32 E{args.in[0], out, D};
        pg8::gemm_phase<pg8::EpiResF32, pg8::StaticOrder, true, true>(lds + RING_OFF, g, S, E);
        if (BOTH(7)) GRID_BAR();
    }
    if (IN(8)) {
        for (int m = gw; m < M; m += NGW) rms_row_to_bf16(out + (size_t)m * D, args.in[10], XN + (size_t)m * D, lane);
        if (BOTH(8)) GRID_BAR();
    }
    if (IN(9)) {
        pg8::Gemm g{XN, Wdgu_t, M, 2 * FF, D}; pg8::StaticOrder S; S.init(M, 2 * FF, G, bx);
        pg8::EpiSwiGLU E{DACT, FF, 28, 0};
        pg8::gemm_phase<pg8::EpiSwiGLU, pg8::StaticOrder, true, true>(lds + RING_OFF, g, S, E);
        if (BOTH(9)) GRID_BAR();
    }
    if (IN(10)) {
        pg8::Gemm g{DACT, Wddn_t, M, D, FF}; pg8::StaticOrder S; S.init(M, D, G, bx);
        pg8::EpiResF32 E{out, out, D};
        pg8::gemm_phase<pg8::EpiResF32, pg8::StaticOrder, true, true>(lds + RING_OFF, g, S, E);
        if (BOTH(10)) GRID_BAR();
    }
    if (IN(11)) {
        for (int m = gw; m < M; m += NGW) rms_row_to_bf16(out + (size_t)m * D, args.in[14], XN + (size_t)m * D, lane);
        LAS float* scr = (LAS float*)(lds + RING_OFF + wave * 16384);
        constexpr int I_G = 16 * 112, I_GU = NE * 2 * I_G, I_DN = NE * 56 * 32;
        for (int it = gw; it < I_GU + I_DN; it += NGW) {
            if (it < I_GU) { const int e = it / (2 * I_G), r1 = it % (2 * I_G), which = r1 / I_G, rr = r1 % I_G, kb = rr / 112, nb = rr % 112, n0 = 32 * nb;
                const int drow = e * 2 * FF + 256 * (n0 / 128) + 128 * which + (n0 % 128);
                transpose_item(args.in[27 + which] + (size_t)e * D * FF, FF, 64 * kb, n0, Mgu_t + (size_t)drow * 1024 + 64 * kb, 1024, scr, lane); }
            else { const int r = it - I_GU, e = r / (56 * 32), rr = r % (56 * 32), kb = rr / 32, nb = rr % 32, k0 = 64 * kb, p = k0 / FFH;
                transpose_item(args.in[29] + (size_t)e * FF * D, D, k0, 32 * nb, Mdn_t + (size_t)p * (NE * 1024) * FFH + (size_t)(e * 1024 + 32 * nb) * FFH + (k0 - p * FFH), FFH, scr, lane); }
        }
        if (BOTH(11)) GRID_BAR();
    }
    if (IN(12)) {
        pg8::Gemm g{XN, Wsin_t, M, SW, D}; pg8::StaticOrder S; S.init(M, SW, G, bx);
        pg8::EpiResF32 E{nullptr, Ub, SW};
        pg8::gemm_phase<pg8::EpiResF32, pg8::StaticOrder, true, true>(lds + RING_OFF, g, S, E);
        if (BOTH(12)) GRID_BAR();
    }
    if (IN(13)) {
        LAS float* us = (LAS float*)(lds + RING_OFF + wave * 8192);
        for (int item = gw; item < NB * 32 * NCH; item += NGW) {
            const int b = item / (32 * NCH), g = (item / NCH) % 32, c = item % NCH;
            const float* tb = STAB + (size_t)g * 36 * 64 + lane;
            const float lre = tb[0], lim = tb[64]; float bre[16], bim[16];
#pragma unroll
            for (int k = 0; k < 16; ++k) { bre[k] = tb[(4 + k) * 64]; bim[k] = tb[(20 + k) * 64]; }
            const size_t m0 = (size_t)b * SEQ + (size_t)c * CH;
#pragma unroll
            for (int i = 0; i < 8; ++i) { const int e = lane + 64 * i, row = e >> 2, q = e & 3; *(LAS f32x4*)(us + row * 16 + 4 * q) = *(const f32x4*)(Ub + (m0 + row) * SW + 16 * g + 4 * q); }
            LDS_WAIT(); asm volatile("" ::: "memory");
            float hr = 0.f, hi2 = 0.f;
#pragma unroll 4
            for (int t = 0; t < CH; ++t) {
                float ur = 0.f, ui = 0.f;
#pragma unroll
                for (int q = 0; q < 4; ++q) { const f32x4 uv = *(const LAS f32x4*)(us + t * 16 + 4 * q);
                    ur += bre[4 * q] * uv.x + bre[4 * q + 1] * uv.y + bre[4 * q + 2] * uv.z + bre[4 * q + 3] * uv.w;
                    ui += bim[4 * q] * uv.x + bim[4 * q + 1] * uv.y + bim[4 * q + 2] * uv.z + bim[4 * q + 3] * uv.w; }
                const float nr = lre * hr - lim * hi2 + ur, ni = lre * hi2 + lim * hr + ui; hr = nr; hi2 = ni;
            }
            *(f32x2*)(HEND + ((size_t)item * 64 + lane) * 2) = (f32x2){hr, hi2};
            LDS_WAIT(); asm volatile("" ::: "memory");
        }
        if (BOTH(13)) GRID_BAR();
    }
    if (IN(14)) {
        LAS float* us = (LAS float*)(lds + RING_OFF + wave * 8192);
        LAS unsigned char* hs = lds + RING_OFF + 65536 + wave * 4352;
        const float* cre_p = args.in[21]; const float* cim_p = args.in[22]; const float* dsk_p = args.in[23];
        const int cc = lane & 15, kq = lane >> 4;
        for (int item = gw; item < NB * 32 * NCH; item += NGW) {
            const int b = item / (32 * NCH), g = (item / NCH) % 32, c = item % NCH;
            const float* tb = STAB + (size_t)g * 36 * 64 + lane;
            const float lre = tb[0], lim = tb[64], lLre = tb[128], lLim = tb[192]; float bre[16], bim[16];
#pragma unroll
            for (int k = 0; k < 16; ++k) { bre[k] = tb[(4 + k) * 64]; bim[k] = tb[(20 + k) * 64]; }
            bf16x8 cm[4];
#pragma unroll
            for (int ks = 0; ks < 4; ++ks) { const int k0 = 32 * ks + 8 * kq; const float* src = (ks < 2 ? cre_p : cim_p) + ((size_t)(g * 16 + cc) * 64 + (k0 & 63)); const float sg = ks < 2 ? 1.f : -1.f;
                const f32x4 a = *(const f32x4*)src, bq = *(const f32x4*)(src + 4);
                v4u t; t.x = pk2(sg * a.x, sg * a.y); t.y = pk2(sg * a.z, sg * a.w); t.z = pk2(sg * bq.x, sg * bq.y); t.w = pk2(sg * bq.z, sg * bq.w); cm[ks] = __builtin_bit_cast(bf16x8, t); }
            const float dsk = dsk_p[16 * g + cc];
            float hr = 0.f, hi2 = 0.f;
            { const float* he = HEND + ((size_t)(item - c) * 64 + lane) * 2;
              for (int c2 = 0; c2 < c; ++c2) { const f32x2 e = *(const f32x2*)(he + (size_t)c2 * 128); const float nr = lLre * hr - lLim * hi2 + e.x, ni = lLre * hi2 + lLim * hr + e.y; hr = nr; hi2 = ni; } }
            const size_t m0 = (size_t)b * SEQ + (size_t)c * CH;
#pragma unroll
            for (int i = 0; i < 8; ++i) { const int e = lane + 64 * i, row = e >> 2, q = e & 3; *(LAS f32x4*)(us + row * 16 + 4 * q) = *(const f32x4*)(Ub + (m0 + row) * SW + 16 * g + 4 * q); }
            LDS_WAIT(); asm volatile("" ::: "memory");
            for (int tb16 = 0; tb16 < CH / 16; ++tb16) {
#pragma unroll 4
                for (int tt = 0; tt < 16; ++tt) {
                    const int t = tb16 * 16 + tt;
                    float ur = 0.f, ui = 0.f;
#pragma unroll
                    for (int q = 0; q < 4; ++q) { const f32x4 uv = *(const LAS f32x4*)(us + t * 16 + 4 * q);
                        ur += bre[4 * q] * uv.x + bre[4 * q + 1] * uv.y + bre[4 * q + 2] * uv.z + bre[4 * q + 3] * uv.w;
                        ui += bim[4 * q] * uv.x + bim[4 * q + 1] * uv.y + bim[4 * q + 2] * uv.z + bim[4 * q + 3] * uv.w; }
                    const float nr = lre * hr - lim * hi2 + ur, ni = lre * hi2 + lim * hr + ui; hr = nr; hi2 = ni;
                    *(LAS unsigned short*)(hs + tt * 272 + lane * 2) = (unsigned short)f2bf(hr);
                    *(LAS unsigned short*)(hs + tt * 272 + 128 + lane * 2) = (unsigned short)f2bf(hi2);
                }
                LDS_WAIT(); asm volatile("" ::: "memory");
                f32x4 acc = {0.f, 0.f, 0.f, 0.f};
#pragma unroll
                for (int ks = 0; ks < 4; ++ks) { const bf16x8 a = *(const LAS bf16x8*)(hs + cc * 272 + (32 * ks + 8 * kq) * 2); acc = __builtin_amdgcn_mfma_f32_16x16x32_bf16(a, cm[ks], acc, 0, 0, 0); }
#pragma unroll
                for (int jj = 0; jj < 4; ++jj) { const int t = tb16 * 16 + 4 * kq + jj; const float uu = us[t * 16 + cc]; const float yv = gelu_tanh(acc[jj] + dsk * uu);
                    Yb[(m0 + t) * SW + 16 * g + cc] = (bf16)f2bf(yv); }
                LDS_WAIT(); asm volatile("" ::: "memory");
            }
        }
        if (BOTH(14)) GRID_BAR();
    }
    if (IN(15)) {
        pg8::Gemm g{Yb, Wglu_t, M, 2048, SW}; pg8::StaticOrder S; S.init(M, 2048, G, bx);
        pg8::EpiGLU E{out, D};
        pg8::gemm_phase<pg8::EpiGLU, pg8::StaticOrder, true, true>(lds + RING_OFF, g, S, E);
        if (BOTH(15)) GRID_BAR();
    }
    if (IN(16)) {
        LAS float* rt = (LAS float*)(lds + RING_OFF);
        LAS int* sel_e = (LAS int*)(lds + RING_OFF + 32768);
        LAS float* sel_w = (LAS float*)(lds + RING_OFF + 32768 + 4096);
        LAS int* ebase = (LAS int*)(lds + RING_OFF + 32768 + 8192);
        const float* rw = args.in[26];
        for (int i = tid; i < 2048; i += NWAVES * 64) ((LAS f32x4*)rt)[i] = ((const f32x4*)rw)[i];
        __syncthreads();
        const int tpb = (M + G - 1) / G;
        const int m_lo = vcu * tpb, m_hi = (m_lo + tpb < M) ? m_lo + tpb : M;
        const float* gn = args.in[25];
        for (int m = m_lo + wave; m < m_hi; m += NWAVES) {
            const f32x4* xr = (const f32x4*)(out + (size_t)m * D) + lane; const f32x4* gr = (const f32x4*)gn + lane;
            f32x4 v[4]; float s = 0.f;
#pragma unroll
            for (int j = 0; j < 4; ++j) { v[j] = xr[64 * j]; s += (v[j].x * v[j].x + v[j].y * v[j].y) + (v[j].z * v[j].z + v[j].w * v[j].w); }
            const float rstd = 1.0f / sqrtf(wave_sum(s) * (1.f / D) + EPS);
            float lg[8];
#pragma unroll
            for (int e = 0; e < 8; ++e) lg[e] = 0.f;
            unsigned long long* o8 = (unsigned long long*)(XN + (size_t)m * D) + lane;
#pragma unroll
            for (int j = 0; j < 4; ++j) { const f32x4 g4 = gr[64 * j]; const float y[4] = {v[j].x * rstd * g4.x, v[j].y * rstd * g4.y, v[j].z * rstd * g4.z, v[j].w * rstd * g4.w};
                o8[64 * j] = (unsigned long long)pk2(y[0], y[1]) | ((unsigned long long)pk2(y[2], y[3]) << 32);
#pragma unroll
                for (int q = 0; q < 4; ++q) { const int k = 256 * j + 4 * lane + q; const f32x4 r0 = *(const LAS f32x4*)(rt + k * 8), r1 = *(const LAS f32x4*)(rt + k * 8 + 4);
                    lg[0] += y[q] * r0.x; lg[1] += y[q] * r0.y; lg[2] += y[q] * r0.z; lg[3] += y[q] * r0.w; lg[4] += y[q] * r1.x; lg[5] += y[q] * r1.y; lg[6] += y[q] * r1.z; lg[7] += y[q] * r1.w; } }
#pragma unroll
            for (int e = 0; e < 8; ++e) lg[e] = wave_sum(lg[e]);
            int e0 = 0; float v0 = lg[0];
#pragma unroll
            for (int e = 1; e < 8; ++e) if (lg[e] > v0) { v0 = lg[e]; e0 = e; }
            int e1 = -1; float v1 = -INFINITY;
#pragma unroll
            for (int e = 0; e < 8; ++e) if (e != e0 && lg[e] > v1) { v1 = lg[e]; e1 = e; }
            const float g1 = 1.0f / (1.0f + expf(v0 - v1)), g0 = 1.0f - g1;
            if (lane == 0) { const int tl = m - m_lo; sel_e[2 * tl] = e0; sel_e[2 * tl + 1] = e1; sel_w[2 * tl] = g0; sel_w[2 * tl + 1] = g1; }
        }
        __syncthreads();
        const int ntl = m_hi - m_lo;
        if (tid < 8 && ntl > 0) { int n = 0; for (int i = 0; i < 2 * ntl; ++i) n += (sel_e[i] == tid) ? 1 : 0;
            ebase[tid] = n ? (int)__hip_atomic_fetch_add(ctl + CW_CNT + 64 * tid, (unsigned)n, RLX_AGENT) : 0; }
        __syncthreads();
        if (tid < 8 && ntl > 0) { int pos = ebase[tid]; for (int i = 0; i < 2 * ntl; ++i) if (sel_e[i] == tid) { LTOK[(size_t)tid * M + pos] = m_lo + (i >> 1); LW[(size_t)tid * M + pos] = sel_w[i]; ++pos; } }
        if (BOTH(16)) GRID_BAR();
    }
    if (IN(17)) {
        LAS int* tinfo = (LAS int*)(lds + RING_OFF);
        if (tid == 0) { int acc = 0; for (int e = 0; e < 8; ++e) { const int cnt = (int)__hip_atomic_load(ctl + CW_CNT + 64 * e, RLX_AGENT); const int nt = (cnt + 255) >> 8; tinfo[e] = cnt; tinfo[8 + e] = acc;
                for (int i = 0; i < nt; ++i) tinfo[32 + acc + i] = e; acc += nt; } tinfo[16] = acc; }
        __syncthreads();
        const int nrt = tinfo[16];
        if (bx == 0) { int t2 = tid; asm volatile("" : "+v"(t2)); if (t2 < nrt) TILEE[t2] = tinfo[32 + t2]; if (tid == 0) TILEE[200] = nrt; }
        for (int s = gw; s < nrt * 256; s += NGW) {
            const int e = tinfo[32 + (s >> 8)], idxe = s - tinfo[8 + e] * 256;
            v4u a = {0u, 0u, 0u, 0u}, b2 = {0u, 0u, 0u, 0u}; int tok = -1; float w = 0.f;
            if (idxe < tinfo[e]) { tok = LTOK[(size_t)e * M + idxe]; w = LW[(size_t)e * M + idxe]; const v4u* src = (const v4u*)(XN + (size_t)tok * D); a = src[lane]; b2 = src[64 + lane]; }
            v4u* dst = (v4u*)(XS + (size_t)s * D); dst[lane] = a; dst[64 + lane] = b2;
            if (lane == 0) { STOK[s] = tok; SWT[s] = w; }
        }
        if (BOTH(17)) GRID_BAR();
    }
#define MOE_PASS(PH, P) \
    if (IN(PH)) { const int nrt = __builtin_amdgcn_readfirstlane(TILEE[200]); \
        pg8::Gemm g{XS, Mgu_t, MAXSLOT, NE * 2 * FF, D}; pg8::MoeOrder S{TILEE, nrt, 14, 28, 14 * (P), G, vcu}; \
        pg8::EpiSwiGLU E{MACT, FFH, 28, 14 * (P)}; \
        pg8::gemm_phase<pg8::EpiSwiGLU, pg8::MoeOrder, true, true>(lds + RING_OFF, g, S, E); \
        if (BOTH(PH)) GRID_BAR(); } \
    if (IN((PH) + 1)) { const int nrt = __builtin_amdgcn_readfirstlane(TILEE[200]); \
        pg8::Gemm g{MACT, Mdn_t + (size_t)(P) * (NE * 1024) * FFH, MAXSLOT, NE * 1024, FFH}; pg8::MoeOrder S{TILEE, nrt, 4, 4, 0, G, vcu}; \
        pg8::EpiMoeDown E{out, STOK, SWT}; \
        pg8::gemm_phase<pg8::EpiMoeDown, pg8::MoeOrder, true, true>(lds + RING_OFF, g, S, E); \
        if (BOTH((PH) + 1)) GRID_BAR(); }
    MOE_PASS(18, 0)
    MOE_PASS(20, 1)
#undef MOE_PASS
#undef IN
#undef BOTH
#undef GRID_BAR
}

extern "C" void kernel_launch(void* const* d_in, const int* in_sizes, int n_in, void* d_out, int out_size, void* d_ws, size_t ws_size, hipStream_t stream) {
    static int grid = 0;
    if (grid == 0) {
        if (n_in != 30 || in_sizes[0] != M * D || out_size != M * D || ws_size < WS_END) { fprintf(stderr, "kernel_launch: unexpected shapes (n_in %d, in0 %d, out %d, ws %zu < %zu); nothing launched\n", n_in, n_in > 0 ? in_sizes[0] : -1, out_size, ws_size, (size_t)WS_END); grid = -1; return; }
        int dev = 0, cus = 0, per_cu = 0;
        if (hipGetDevice(&dev) != hipSuccess || hipDeviceGetAttribute(&cus, hipDeviceAttributeMultiprocessorCount, dev) != hipSuccess) { grid = -1; return; }
        if (hipFuncSetAttribute((const void*)fwd, hipFuncAttributeMaxDynamicSharedMemorySize, LDS_BYTES) != hipSuccess) { fprintf(stderr, "kernel_launch: hipFuncSetAttribute failed\n"); grid = -1; return; }
        if (hipOccupancyMaxActiveBlocksPerMultiprocessor(&per_cu, (const void*)fwd, NWAVES * 64, LDS_BYTES) != hipSuccess || per_cu < 1) { fprintf(stderr, "kernel_launch: occupancy query reports %d blocks per CU\n", per_cu); (void)hipGetLastError(); grid = -1; return; }
        grid = cus;
    }
    if (grid < 0) return;
    if (hipMemsetAsync((char*)d_ws + WS_CTL, 0, CTL_ZERO_BYTES, stream) != hipSuccess) return;
    Args a{};
    for (int i = 0; i < 30; ++i) a.in[i] = (const float*)d_in[i];
    a.out = (float*)d_out; a.ws = (unsigned char*)d_ws;
#if MK_PER_PHASE
    for (int p = 0; p < NPH; ++p) { a.ph_lo = p; a.ph_hi = p + 1; hipLaunchKernelGGL(fwd, dim3(grid), dim3(NWAVES * 64), LDS_BYTES, stream, a); }
#else
    a.ph_lo = 0; a.ph_hi = NPH; hipLaunchKernelGGL(fwd, dim3(grid), dim3(NWAVES * 64), LDS_BYTES, stream, a);
#endif
}
```

```cpp
#include <hip/hip_runtime.h>
#include <cstdio>
#include <cstdint>
#include <cmath>
namespace pg8 {
#define PG8_LAS __attribute__((address_space(3)))
typedef unsigned short bf16_t;
typedef short bf16x8 __attribute__((ext_vector_type(8)));
typedef float f32x4 __attribute__((ext_vector_type(4)));
typedef unsigned u32x4 __attribute__((ext_vector_type(4)));
constexpr int BM = 256, BK = 64, HALF = 128, HTB = HALF * BK * 2  , STAGE_BYTES = 8 * HTB, NXCD = 8, WGM = 8;

__host__ __device__ __forceinline__ int lds_byte(int r, int c) { const int st = (r >> 4) * 2 + (c >> 5), rr = r & 15, cc = c & 31, ob = rr * 64 + cc * 2; return st * 1024 + (ob ^ (((ob >> 9) & 1) << 5)); }
__host__ __device__ __forceinline__ void stage_rc(int b, int& R, int& C) { const int st = b / 1024, sb = b % 1024, swz = sb ^ (((sb >> 9) & 1) << 5); R = (st >> 1) * 16 + swz / 64; C = (st & 1) * 32 + (swz % 64) / 2; }
__host__ __device__ __forceinline__ int perm32(int rho) { const int n = rho >> 4, i = rho & 15; return 8 * (i >> 2) + 4 * n + (i & 3); }

struct Unit { int pm, pn; };
struct Gemm { const bf16_t* A; const bf16_t* Bt; int M, N, K; };

struct StaticOrder {
    int nM, nN, nwg, G, c;
    __host__ __device__ void init(int M, int N, int G_, int c_) { nM = M / BM; nN = N / BM; nwg = nM * nN; G = G_; c = c_; }
    __host__ __device__ bool next(int i, Unit& u) const {
        const long L = (long)i * G + c; if (L >= nwg) return false;
        int wgid = (int)L; { const int q = nwg / NXCD, r = nwg % NXCD, xcd = wgid % NXCD, off = wgid / NXCD; wgid = (xcd < r ? xcd * (q + 1) : r * (q + 1) + (xcd - r) * q) + off; }
        const int nig = WGM * nN, gid = wgid / nig, fm = gid * WGM, gsz = (nM - fm) < WGM ? (nM - fm) : WGM;
        u.pm = fm + ((wgid % nig) % gsz); u.pn = (wgid % nig) / gsz; return true;
    }
    __device__ __forceinline__ void a_ready(const Unit&) const {}
    __device__ __forceinline__ void done(const Unit&) const {}
};

__device__ __forceinline__ unsigned cvt_pk_bf16(float lo, float hi) { unsigned r; asm volatile("v_cvt_pk_bf16_f32 %0, %1, %2" : "=v"(r) : "v"(lo), "v"(hi)); return r; }
typedef float f32x2 __attribute__((ext_vector_type(2)));
typedef float f32x2 __attribute__((ext_vector_type(2)));
__device__ __forceinline__ float fast_sigmoid(float x) { return __builtin_amdgcn_rcpf(1.0f + __expf(-x)); }
struct EpiBf16Plain {
    static constexpr bool PERM = true, AFTER_DRAIN = false;
    bf16_t* O; int ldc;
    __device__ __forceinline__ void operator()(const f32x4 (&acc)[2][2][4][2], const Unit& u, int wr, int wc, int fr, int fq) const {
        const int row0 = u.pm * BM + wr * 64 + fr, col0 = u.pn * BM + wc * 32 + 8 * fq;
#pragma unroll
        for (int ai = 0; ai < 2; ++ai)
#pragma unroll
            for (int m = 0; m < 4; ++m) { bf16_t* rowp = O + (size_t)(row0 + ai * HALF + m * 16) * ldc + col0;
#pragma unroll
                for (int bj = 0; bj < 2; ++bj) { const f32x4 v0 = acc[ai][bj][m][0], v1 = acc[ai][bj][m][1];
                    u32x4 w; w.x = cvt_pk_bf16(v0[0], v0[1]); w.y = cvt_pk_bf16(v0[2], v0[3]); w.z = cvt_pk_bf16(v1[0], v1[1]); w.w = cvt_pk_bf16(v1[2], v1[3]);
                    *(u32x4*)(rowp + bj * HALF) = w; } }
    }
};
struct EpiResF32 {
    static constexpr bool PERM = false, AFTER_DRAIN = false;
    const float* base; float* out; int ldc; float scale;
    __device__ __forceinline__ void operator()(const f32x4 (&acc)[2][2][4][2], const Unit& u, int wr, int wc, int fr, int fq) const {
        const int col0 = u.pn * BM + wc * 32 + 4 * fq;
#pragma unroll
        for (int ai = 0; ai < 2; ++ai)
#pragma unroll
            for (int m = 0; m < 4; ++m) { const int r = ai * HALF + wr * 64 + m * 16 + fr; const size_t off = (size_t)(u.pm * BM + r) * ldc + col0;
#pragma unroll
                for (int bj = 0; bj < 2; ++bj)
#pragma unroll
                    for (int n = 0; n < 2; ++n) { const size_t o = off + bj * HALF + n * 16; f32x4 v = acc[ai][bj][m][n] * scale; if (base) v = v + *(const f32x4*)(base + o); *(f32x4*)(out + o) = v; } }
    }
};
struct EpiSwiGLU {
    static constexpr bool PERM = true, AFTER_DRAIN = false;
    bf16_t* O; int ldc, ngrp, sub;
    __device__ __forceinline__ void operator()(const f32x4 (&acc)[2][2][4][2], const Unit& u, int wr, int wc, int fr, int fq) const {
        const int ct = (u.pn % ngrp) - sub; const int row0 = u.pm * BM + wr * 64 + fr, col0 = ct * HALF + wc * 32 + 8 * fq;
#pragma unroll
        for (int ai = 0; ai < 2; ++ai)
#pragma unroll
            for (int m = 0; m < 4; ++m) { bf16_t* rowp = O + (size_t)(row0 + ai * HALF + m * 16) * ldc + col0;
                f32x4 a[2];
#pragma unroll
                for (int n = 0; n < 2; ++n) { const f32x4 g = acc[ai][0][m][n], up = acc[ai][1][m][n];
#pragma unroll
                    for (int j = 0; j < 4; ++j) a[n][j] = g[j] * fast_sigmoid(g[j]) * up[j]; }
                u32x4 w; w.x = cvt_pk_bf16(a[0][0], a[0][1]); w.y = cvt_pk_bf16(a[0][2], a[0][3]); w.z = cvt_pk_bf16(a[1][0], a[1][1]); w.w = cvt_pk_bf16(a[1][2], a[1][3]);
                *(u32x4*)rowp = w; }
    }
};
struct EpiGLU {
    static constexpr bool PERM = false, AFTER_DRAIN = false;
    float* out; int ldc; float scale;
    __device__ __forceinline__ void operator()(const f32x4 (&acc)[2][2][4][2], const Unit& u, int wr, int wc, int fr, int fq) const {
        const int col0 = u.pn * HALF + wc * 32 + 4 * fq;
#pragma unroll
        for (int ai = 0; ai < 2; ++ai)
#pragma unroll
            for (int m = 0; m < 4; ++m) { const int r = ai * HALF + wr * 64 + m * 16 + fr; const size_t off = (size_t)(u.pm * BM + r) * ldc + col0;
#pragma unroll
                for (int n = 0; n < 2; ++n) { const size_t o = off + n * 16; const f32x4 a = acc[ai][0][m][n], g = acc[ai][1][m][n]; f32x4 v = *(const f32x4*)(out + o);
#pragma unroll
                    for (int j = 0; j < 4; ++j) v[j] += scale * a[j] * fast_sigmoid(g[j]);
                    *(f32x4*)(out + o) = v; } }
    }
};
struct EpiMoeDown {
    static constexpr bool PERM = false, AFTER_DRAIN = false;
    float* out; bf16_t* Y1; const int* slot_tok; const float* slot_w; float scale; int first; int ntok;
    __device__ __forceinline__ void operator()(const f32x4 (&acc)[2][2][4][2], const Unit& u, int wr, int wc, int fr, int fq) const {
        typedef unsigned u32x2 __attribute__((ext_vector_type(2)));
        const int colb = (u.pn & 3) * BM + wc * 32 + 4 * fq;
#pragma unroll
        for (int ai = 0; ai < 2; ++ai)
#pragma unroll
            for (int m = 0; m < 4; ++m) { const int s = u.pm * BM + ai * HALF + wr * 64 + m * 16 + fr; const int tv = slot_tok[s]; const float w = slot_w[s] * scale;
                if (tv >= 0 && tv < ntok) { float* orow = out + (size_t)tv * 1024 + colb;
#pragma unroll
                    for (int bj = 0; bj < 2; ++bj)
#pragma unroll
                        for (int n = 0; n < 2; ++n) { float* p = orow + bj * HALF + n * 16; *(f32x4*)p = *(const f32x4*)p + acc[ai][bj][m][n] * w; } }
                else if (tv >= ntok) { bf16_t* yrow = Y1 + (size_t)(tv - ntok) * 1024 + colb;
#pragma unroll
                    for (int bj = 0; bj < 2; ++bj)
#pragma unroll
                        for (int n = 0; n < 2; ++n) { bf16_t* p = yrow + bj * HALF + n * 16; f32x4 v = acc[ai][bj][m][n] * w;
                            if (!first) { const u32x2 o = *(const u32x2*)p; v[0] += __uint_as_float(o.x << 16); v[1] += __uint_as_float(o.x & 0xffff0000u); v[2] += __uint_as_float(o.y << 16); v[3] += __uint_as_float(o.y & 0xffff0000u); }
                            u32x2 r; r.x = cvt_pk_bf16(v[0], v[1]); r.y = cvt_pk_bf16(v[2], v[3]); *(u32x2*)p = r; } } }
    }
};
struct MoeOrder {
    const int* tile_e; int nrt, ncol, mul, coloff, G, c;
    __device__ __forceinline__ bool next(int i, Unit& u) const {
        const int L = i * G + c; if (L >= nrt * ncol) return false;
        const int rt = L / ncol, jj = L - rt * ncol; const int e = __builtin_amdgcn_readfirstlane(tile_e[rt]);
        u.pm = rt; u.pn = e * mul + coloff + jj; return true;
    }
    __device__ __forceinline__ void a_ready(const Unit&) const {}
    __device__ __forceinline__ void done(const Unit&) const {}
};

template <class Epi, class Sched, bool ALIGN_EPI = false, bool SP2 = false>
__device__ __forceinline__ void gemm_phase(PG8_LAS unsigned char* lds, const Gemm g, const Sched& S, const Epi& E) {
    const int tid = threadIdx.x, wid = __builtin_amdgcn_readfirstlane(tid >> 6), lane = tid & 63, wr = wid >> 2, wc = wid & 3, fr = lane & 15, fq = lane >> 4;
    const int K = g.K, nt = K / BK;
    unsigned voffA[2], voffB[2];
#pragma unroll
    for (int i = 0; i < 2; ++i) { int R, C; stage_rc(tid * 16 + i * 8192, R, C); const int Rb = Epi::PERM ? ((R & ~31) + perm32(R & 31)) : R;
        voffA[i] = (unsigned)(R * K + C) * 2u; voffB[i] = (unsigned)(Rb * K + C) * 2u; }
    const size_t kstep = (size_t)(BK * 2);
    const size_t hstep = (size_t)HALF * K * 2;
    const size_t tstep = 2 * hstep;
    const unsigned ldsw = (unsigned)wid * 1024u;
    const int aoff = lds_byte(wr * 64 + fr, fq * 8), boff = lds_byte(wc * 32 + fr, fq * 8);
#define PG8_SA(b, h) (((b) * 2 + (h)) * HTB)
#define PG8_SB(b, h) ((4 + (b) * 2 + (h)) * HTB)
#define PG8_STAGE(bufoff, gbase, voff) do { _Pragma("unroll") for (int _i = 0; _i < 2; ++_i) \
        __builtin_amdgcn_global_load_lds((const unsigned*)((const char*)(gbase) + (voff)[_i]), (PG8_LAS unsigned*)(lds + (bufoff) + ldsw + _i * 8192), 16, 0, 0); } while (0)
#define PG8_LDA(dst, b, h) do { _Pragma("unroll") for (int m = 0; m < 4; ++m) _Pragma("unroll") for (int k = 0; k < 2; ++k) dst[m][k] = *(const PG8_LAS bf16x8*)(lds + PG8_SA(b, h) + aoff + m * 2048 + k * 1024); } while (0)
#define PG8_LDB(dst, b, h) do { _Pragma("unroll") for (int n = 0; n < 2; ++n) _Pragma("unroll") for (int k = 0; k < 2; ++k) dst[n][k] = *(const PG8_LAS bf16x8*)(lds + PG8_SB(b, h) + boff + n * 2048 + k * 1024); } while (0)
#define PG8_MMA(ai, bj, At, Bt) do { __builtin_amdgcn_s_setprio(1); _Pragma("unroll") for (int m = 0; m < 4; ++m) _Pragma("unroll") for (int n = 0; n < 2; ++n) _Pragma("unroll") for (int k = 0; k < 2; ++k) \
        acc[ai][bj][m][n] = __builtin_amdgcn_mfma_f32_16x16x32_bf16(Bt[n][k], At[m][k], acc[ai][bj][m][n], 0, 0, 0); __builtin_amdgcn_s_setprio(0); } while (0)
#define PG8_WAIT_V(n) asm volatile("s_waitcnt vmcnt(" #n ")" ::: "memory")
#define PG8_WAIT_L(n) asm volatile("s_waitcnt lgkmcnt(" #n ")" ::: "memory")
#define PG8_BAR __builtin_amdgcn_s_barrier()
#define PG8_SCHED __builtin_amdgcn_sched_barrier(0)
    Unit cur, nxt; int ui = 0;
    if (!S.next(0, cur)) return;
    f32x4 acc[2][2][4][2];
#pragma unroll
    for (int a = 0; a < 2; ++a)
#pragma unroll
        for (int b = 0; b < 2; ++b)
#pragma unroll
            for (int m = 0; m < 4; ++m)
#pragma unroll
                for (int n = 0; n < 2; ++n) acc[a][b][m][n] = (f32x4){0.f, 0.f, 0.f, 0.f};
    bf16x8 At[4][2], B0[2][2], B1[2][2];
    const char* cA = (const char*)g.A + (size_t)cur.pm * tstep; const char* cB = (const char*)g.Bt + (size_t)cur.pn * tstep;
    S.a_ready(cur);
    if constexpr (SP2) {
        PG8_STAGE(PG8_SB(0, 0), cB, voffB); PG8_STAGE(PG8_SB(0, 1), cB + hstep, voffB); PG8_STAGE(PG8_SA(0, 0), cA, voffA); PG8_STAGE(PG8_SA(0, 1), cA + hstep, voffA);
        if (wr == 1) PG8_BAR;
        PG8_WAIT_V(2); PG8_BAR;
        PG8_STAGE(PG8_SB(1, 0), cB + kstep, voffB); PG8_STAGE(PG8_SA(1, 0), cA + kstep, voffA); PG8_STAGE(PG8_SB(1, 1), cB + hstep + kstep, voffB);
        PG8_WAIT_V(6); PG8_BAR;
    } else {
        PG8_STAGE(PG8_SB(0, 0), cB, voffB); PG8_STAGE(PG8_SA(0, 0), cA, voffA); PG8_STAGE(PG8_SB(0, 1), cB + hstep, voffB); PG8_STAGE(PG8_SA(0, 1), cA + hstep, voffA);
        if (wr == 1) PG8_BAR;
        PG8_WAIT_V(4); PG8_BAR;
        PG8_STAGE(PG8_SB(1, 0), cB + kstep, voffB); PG8_STAGE(PG8_SA(1, 0), cA + kstep, voffA); PG8_STAGE(PG8_SB(1, 1), cB + hstep + kstep, voffB);
        PG8_WAIT_V(6); PG8_BAR;
    }
    for (;;) {
        const bool has_next = S.next(ui + 1, nxt);
        const char* nA = has_next ? (const char*)g.A + (size_t)nxt.pm * tstep : cA; const char* nB = has_next ? (const char*)g.Bt + (size_t)nxt.pn * tstep : cB;
        for (int t = 0; t < nt; t += 2) {
            const bool last = (t == nt - 2);
            const char* a1 = cA + (size_t)(t + 1) * kstep;
            const char* a2 = last ? nA : cA + (size_t)(t + 2) * kstep; const char* b2 = last ? nB : cB + (size_t)(t + 2) * kstep;
            const char* a3 = a2 + kstep; const char* b3 = b2 + kstep;
            if (last && has_next) S.a_ready(nxt);
            if constexpr (SP2) {
            PG8_LDB(B0, 0, 0); PG8_LDB(B1, 0, 1); PG8_SCHED; PG8_LDA(At, 0, 0); PG8_STAGE(PG8_SA(1, 1), a1 + hstep, voffA);
            PG8_WAIT_V(8); PG8_WAIT_L(0); PG8_BAR; PG8_MMA(0, 0, At, B0); PG8_MMA(0, 1, At, B1); PG8_BAR; PG8_SCHED;
            PG8_LDA(At, 0, 1); PG8_STAGE(PG8_SB(0, 0), b2, voffB); PG8_STAGE(PG8_SB(0, 1), b2 + hstep, voffB); PG8_STAGE(PG8_SA(0, 0), a2, voffA);
            PG8_WAIT_V(8); PG8_WAIT_L(0); PG8_BAR; PG8_MMA(1, 0, At, B0); PG8_MMA(1, 1, At, B1); PG8_BAR; PG8_SCHED;
            PG8_LDB(B0, 1, 0); PG8_LDB(B1, 1, 1); PG8_SCHED; PG8_LDA(At, 1, 0); PG8_STAGE(PG8_SA(0, 1), a2 + hstep, voffA);
            PG8_WAIT_V(8); PG8_WAIT_L(0); PG8_BAR; PG8_MMA(0, 0, At, B0); PG8_MMA(0, 1, At, B1); PG8_BAR; PG8_SCHED;
            PG8_LDA(At, 1, 1); PG8_STAGE(PG8_SB(1, 0), b3, voffB); PG8_STAGE(PG8_SB(1, 1), b3 + hstep, voffB); PG8_STAGE(PG8_SA(1, 0), a3, voffA);
            PG8_WAIT_V(8); PG8_WAIT_L(0); PG8_BAR; PG8_MMA(1, 0, At, B0); PG8_MMA(1, 1, At, B1); PG8_BAR; PG8_SCHED;
            } else {
            PG8_LDB(B0, 0, 0); PG8_SCHED; PG8_LDA(At, 0, 0); PG8_STAGE(PG8_SA(1, 1), a1 + hstep, voffA);
            PG8_WAIT_L(8); PG8_BAR; PG8_WAIT_L(0); PG8_MMA(0, 0, At, B0); PG8_BAR; PG8_SCHED;
            PG8_LDB(B1, 0, 1); PG8_STAGE(PG8_SB(0, 0), b2, voffB);
            PG8_BAR; PG8_WAIT_L(0); PG8_MMA(0, 1, At, B1); PG8_BAR;
            PG8_LDA(At, 0, 1); PG8_STAGE(PG8_SA(0, 0), a2, voffA);
            PG8_BAR; PG8_WAIT_L(0); PG8_MMA(1, 0, At, B0); PG8_BAR; PG8_SCHED;
            PG8_STAGE(PG8_SB(0, 1), b2 + hstep, voffB);
            PG8_WAIT_V(6); PG8_BAR; PG8_MMA(1, 1, At, B1); PG8_BAR;
            PG8_LDB(B0, 1, 0); PG8_SCHED; PG8_LDA(At, 1, 0); PG8_STAGE(PG8_SA(0, 1), a2 + hstep, voffA);
            PG8_WAIT_L(8); PG8_BAR; PG8_WAIT_L(0); PG8_MMA(0, 0, At, B0); PG8_BAR; PG8_SCHED;
            PG8_LDB(B1, 1, 1); PG8_STAGE(PG8_SB(1, 0), b3, voffB);
            PG8_BAR; PG8_WAIT_L(0); PG8_MMA(0, 1, At, B1); PG8_BAR;
            PG8_LDA(At, 1, 1); PG8_STAGE(PG8_SA(1, 0), a3, voffA);
            PG8_BAR; PG8_WAIT_L(0); PG8_MMA(1, 0, At, B0); PG8_BAR; PG8_SCHED;
            PG8_STAGE(PG8_SB(1, 1), b3 + hstep, voffB);
            PG8_WAIT_V(6); PG8_BAR; PG8_MMA(1, 1, At, B1); PG8_BAR;
            }
        }
        if constexpr (ALIGN_EPI) { if (wr == 0) PG8_BAR; }
        if constexpr (!Epi::AFTER_DRAIN) { E(acc, cur, wr, wc, fr, fq); S.done(cur); }
        if (!has_next) break;
#pragma unroll
        for (int a = 0; a < 2; ++a)
#pragma unroll
            for (int b = 0; b < 2; ++b)
#pragma unroll
                for (int m = 0; m < 4; ++m)
#pragma unroll
                    for (int n = 0; n < 2; ++n) acc[a][b][m][n] = (f32x4){0.f, 0.f, 0.f, 0.f};
        cur = nxt; cA = nA; cB = nB; ++ui;
        if constexpr (ALIGN_EPI) { if (wr == 1) PG8_BAR; }
    }
    PG8_WAIT_V(0);
    if constexpr (!ALIGN_EPI) { if (wr == 0) PG8_BAR; }
    PG8_BAR;
    if constexpr (Epi::AFTER_DRAIN) { E.fused(acc, cur, wr, wc, fr, fq, lds, wid, lane); S.done(cur); }
#undef PG8_SA
#undef PG8_SB
#undef PG8_STAGE
#undef PG8_LDA
#undef PG8_LDB
#undef PG8_MMA
#undef PG8_WAIT_V
#undef PG8_WAIT_L
#undef PG8_BAR
#undef PG8_SCHED
}
}
#define LAS __attribute__((address_space(3)))
#define XB_TMO      128
#define XB_XCNT(j)  (256  + 64 * (j))
#define XB_XSUB(j)  (1280 + 64 * (j))
#define XB_XGEN(j)  (2304 + 64 * (j))
#define XB_TOP      3328
#define XB_TOPGEN   3392
#define XCD_BAR_WORDS 3456
#define XB_SPIN_CAP (1u << 18)

__device__ __forceinline__ unsigned xb_ld(unsigned* p)              { return __hip_atomic_load(p, __ATOMIC_RELAXED, __HIP_MEMORY_SCOPE_AGENT); }
__device__ __forceinline__ unsigned xb_add(unsigned* p, unsigned v) { return __hip_atomic_fetch_add(p, v, __ATOMIC_RELAXED, __HIP_MEMORY_SCOPE_AGENT); }
__device__ __forceinline__ unsigned xb_xcc_id() { return (unsigned)__builtin_amdgcn_s_getreg((3 << 11) | 20) & 0xFu; }
#define XB_SPIN(cond, bar) do { unsigned _sp = 0; while (cond) { __builtin_amdgcn_s_sleep(1); \
    if ((++_sp & 255u) == 0u) { if (xb_ld(&(bar)[XB_TMO])) break; if (_sp > XB_SPIN_CAP) { atomicAdd(&(bar)[XB_TMO], 1u); break; } } } } while (0)

struct XcdBarrier {
    unsigned* bar; unsigned x;
    volatile LAS unsigned* st;
};

__device__ __forceinline__ XcdBarrier xcd_barrier_post(unsigned* bar, volatile LAS unsigned* st) {
    XcdBarrier b; b.bar = bar; b.x = xb_xcc_id(); b.st = st;
    if (threadIdx.x == 0) (void)xb_add(&bar[XB_XCNT(b.x)], 1u);
    return b;
}
__device__ __forceinline__ void xcd_barrier_complete(unsigned* bar, unsigned x, unsigned& nloc, unsigned& nx) {
    const unsigned G = gridDim.x * gridDim.y * gridDim.z;
    unsigned sum, cnt, mine, sp = 0u;
    for (;;) {
        sum = 0u; cnt = 0u; mine = 0u;
#pragma unroll
        for (unsigned j = 0; j < 16; ++j) { const unsigned c = xb_ld(&bar[XB_XCNT(j)]); sum += c; cnt += (c > 0u) ? 1u : 0u; mine = (j == x) ? c : mine; }
        if (sum == G) break;
        __builtin_amdgcn_s_sleep(1);
        if ((++sp & 255u) == 0u) { if (xb_ld(&bar[XB_TMO])) break; if (sp > XB_SPIN_CAP) { atomicAdd(&bar[XB_TMO], 1u); break; } }
    }
    nloc = mine > 0u ? mine : 1u; nx = cnt > 0u ? cnt : 1u;
}

__device__ __forceinline__ void xcd_barrier(const XcdBarrier& b) {
    asm volatile("s_waitcnt vmcnt(0)" ::: "memory");
    __syncthreads();
    if (threadIdx.x == 0) {
        unsigned* bar = b.bar;
        __builtin_amdgcn_s_waitcnt(0);
        unsigned nloc = b.st[0], nx = b.st[1];
        if (nloc == 0u) { xcd_barrier_complete(bar, b.x, nloc, nx); b.st[0] = nloc; b.st[1] = nx; }
        const unsigned old = xb_add(&bar[XB_XSUB(b.x)], 1u);
        const unsigned gen = old / nloc;
        if (old + 1u == (gen + 1u) * nloc) {
            __builtin_amdgcn_fence(__ATOMIC_RELEASE, "agent");
            asm volatile("s_waitcnt vmcnt(0)" ::: "memory");
            const unsigned og = xb_add(&bar[XB_TOP], 1u);
            const unsigned tg = og / nx;
            if (og + 1u == (tg + 1u) * nx) xb_add(&bar[XB_TOPGEN], 1u);
            else XB_SPIN(xb_ld(&bar[XB_TOPGEN]) == tg, bar);
            __builtin_amdgcn_fence(__ATOMIC_ACQUIRE, "agent");
            xb_add(&bar[XB_XGEN(b.x)], 1u);
            asm volatile("s_waitcnt vmcnt(0)" ::: "memory");
        } else {
            XB_SPIN(xb_ld(&bar[XB_XGEN(b.x)]) == gen, bar);
            __builtin_amdgcn_fence(__ATOMIC_ACQUIRE, "agent");
            asm volatile("s_waitcnt vmcnt(0)" ::: "memory");
        }
    }
    __syncthreads();
}
#define GAS __attribute__((address_space(1)))
typedef unsigned short bf16;
typedef unsigned v4u __attribute__((ext_vector_type(4)));
typedef unsigned v2u __attribute__((ext_vector_type(2)));
typedef float f32x4 __attribute__((ext_vector_type(4)));
typedef float f32x16 __attribute__((ext_vector_type(16)));
typedef float f32x2 __attribute__((ext_vector_type(2)));
typedef short bf16x8 __attribute__((ext_vector_type(8)));
typedef GAS unsigned gu32;
#define RLX_AGENT __ATOMIC_RELAXED, __HIP_MEMORY_SCOPE_AGENT
#define LDS_WAIT() asm volatile("s_waitcnt lgkmcnt(0)" ::: "memory")
#define VM_WAIT() asm volatile("s_waitcnt vmcnt(0)" ::: "memory")
__device__ __forceinline__ unsigned f2bf(float f) { unsigned u = __builtin_bit_cast(unsigned, f); return (u + 0x7fffu + ((u >> 16) & 1u)) >> 16; }
__device__ __forceinline__ unsigned pk2(float lo, float hi) { return f2bf(lo) | (f2bf(hi) << 16); }
__device__ __forceinline__ float bflo(unsigned u) { return __uint_as_float(u << 16); }
__device__ __forceinline__ float bfhi(unsigned u) { return __uint_as_float(u & 0xffff0000u); }

constexpr int NWAVES = 8;
constexpr int SEQ = 8192, NB = 2, M = NB * SEQ, D = 1024;
constexpr int INC = 1952, INP = 2048;
constexpr int FF = 3584, NE = 8;
constexpr int SW = 512;
constexpr int CH = 128, NCH = SEQ / CH;
constexpr int FFH = FF / 2;
constexpr int MAXSLOT = 2 * M + NE * 256;
constexpr float EPS = 1e-6f;
constexpr size_t MiB = 1u << 20;
constexpr size_t WS_CTL = 0, CTL_ZERO_BYTES = 1 * MiB;
constexpr size_t WS_WIN = 1 * MiB;
constexpr size_t WS_WQUP = 5 * MiB;
constexpr size_t WS_WKVUP = 5 * MiB + 512 * 1024;
constexpr size_t WS_WOUT = 6 * MiB;
constexpr size_t WS_WDGU = 8 * MiB;
constexpr size_t WS_WDDN = 22 * MiB;
constexpr size_t WS_WSIN = 29 * MiB;
constexpr size_t WS_WGLU = 30 * MiB;
constexpr size_t WS_MGU = 32 * MiB;
constexpr size_t WS_MDN = 144 * MiB;
constexpr size_t WS_XN = 200 * MiB;
constexpr size_t WS_H = 32 * MiB;
constexpr size_t WS_QRAW = 96 * MiB;
constexpr size_t WS_KVRAW = 120 * MiB;
constexpr size_t WS_QM = 152 * MiB;
constexpr size_t WS_KM = 176 * MiB;
constexpr size_t WS_MERGED = 232 * MiB;
constexpr size_t WS_CQ = 264 * MiB;
constexpr size_t WS_CKV = 272 * MiB;
constexpr size_t WS_DACT = 32 * MiB;
constexpr size_t WS_U = 232 * MiB;
constexpr size_t WS_HEND = 264 * MiB;
constexpr size_t WS_Y = 266 * MiB;
constexpr size_t WS_XS = 232 * MiB;
constexpr size_t WS_MACT = 300 * MiB;
constexpr size_t WS_LTOK = 420 * MiB;
constexpr size_t WS_LW = 421 * MiB;
constexpr size_t WS_STOK = 422 * MiB;
constexpr size_t WS_SW = 423 * MiB;
constexpr size_t WS_TILEE = 424 * MiB;
constexpr size_t WS_ROPE = 458 * MiB;
constexpr size_t WS_STAB = 459 * MiB;
constexpr size_t WS_END = 460 * MiB;
static_assert(WS_XS + (size_t)MAXSLOT * 1024 * 2 <= WS_MACT && WS_MACT + (size_t)MAXSLOT * FFH * 2 <= WS_LTOK, "moe map");
constexpr int CW_BAR = 4096;
constexpr int CW_QUEUE = 8192;
constexpr int CW_CNT = 8192 + 64;
constexpr int RING_OFF = 0, RING_BYTES = 131072;
constexpr int LDSCTL_OFF = RING_BYTES, MISC_OFF = LDSCTL_OFF + 320;
constexpr int LDS_BYTES = 147456;

__device__ __forceinline__ float wave_sum(float v) {
#pragma unroll
    for (int o = 1; o < 64; o <<= 1) v += __shfl_xor(v, o);
    return v;
}
__device__ __forceinline__ float wave_max(float v) {
#pragma unroll
    for (int o = 1; o < 64; o <<= 1) v = fmaxf(v, __shfl_xor(v, o));
    return v;
}

__device__ __forceinline__ void transpose_item(const float* __restrict__ W, int N, int k0, int n0, bf16* dst, int dpitch, LAS float* scr, int lane) {
#pragma unroll 8
    for (int i = 0; i < 32; ++i) { const int kk = 2 * i + (lane >> 5); scr[kk * 33 + (lane & 31)] = W[(size_t)(k0 + kk) * N + n0 + (lane & 31)]; }
    LDS_WAIT(); asm volatile("" ::: "memory");
    const int c = lane & 7;
#pragma unroll
    for (int j = 0; j < 4; ++j) { const int n = (lane >> 3) + 8 * j; const LAS float* s = scr + (8 * c) * 33 + n;
        v4u o; o.x = pk2(s[0 * 33], s[1 * 33]); o.y = pk2(s[2 * 33], s[3 * 33]); o.z = pk2(s[4 * 33], s[5 * 33]); o.w = pk2(s[6 * 33], s[7 * 33]);
        *(GAS v4u*)(dst + (size_t)n * dpitch + 8 * c) = o; }
    LDS_WAIT(); asm volatile("" ::: "memory");
}
__device__ __forceinline__ void rms_row_to_bf16(const float* xrow, const float* __restrict__ gain, bf16* orow, int lane) {
    const f32x4* xr = (const f32x4*)xrow + lane; const f32x4* gr = (const f32x4*)gain + lane;
    f32x4 v[4]; float s = 0.f;
#pragma unroll
    for (int j = 0; j < 4; ++j) { v[j] = xr[64 * j]; s += (v[j].x * v[j].x + v[j].y * v[j].y) + (v[j].z * v[j].z + v[j].w * v[j].w); }
    const float rstd = 1.0f / sqrtf(wave_sum(s) * (1.f / D) + EPS);
    unsigned long long* o8 = (unsigned long long*)orow + lane;
#pragma unroll
    for (int j = 0; j < 4; ++j) { const f32x4 g = gr[64 * j];
        o8[64 * j] = (unsigned long long)pk2(v[j].x * rstd * g.x, v[j].y * rstd * g.y) | ((unsigned long long)pk2(v[j].z * rstd * g.z, v[j].w * rstd * g.w) << 32); }
}

__device__ __forceinline__ float gelu_tanh(float x) {
    const float a = 0.7978845608028654f * (x + 0.044715f * x * x * x);
    const float t = 1.0f - 2.0f * __builtin_amdgcn_rcpf(1.0f + __expf(2.0f * a));
    return 0.5f * x * (1.0f + t);
}

__device__ __forceinline__ int crow(int r, int hi) { return (r & 3) + 8 * (r >> 2) + 4 * hi; }
template <int DQK, bool SB>
__device__ __forceinline__ void attn_unit(LAS unsigned char* lds, const bf16* Qp, int qpitch, const bf16* Kp, int kpitch, const bf16* Vp, int vpitch, bf16* Op, int opitch, int qb, int tid, int wid, int lane) {
    constexpr int KROW = (DQK + 8) * 2, KS_OFF = 0, VT_OFF = 64 * KROW, VROW = 144, FLAG_OFF = VT_OFF + 64 * VROW, NKS = DQK / 16, KCH = DQK / 8;
    const int r32 = lane & 31, hi = lane >> 5;
    const int qrow0 = qb * 256 + wid * 32;
    bf16x8 qr[NKS];
#pragma unroll
    for (int ks = 0; ks < NKS; ++ks) qr[ks] = *(const bf16x8*)(Qp + (size_t)(qrow0 + r32) * qpitch + ks * 16 + hi * 8);
    f32x16 o0, o1;
#pragma unroll
    for (int r = 0; r < 16; ++r) { o0[r] = 0.f; o1[r] = 0.f; }
    float m_run = -INFINITY, l_run = 0.f, A = 0.f;
    const int ntiles = 4 * qb + 4;
    LAS int* flags = (LAS int*)(lds + FLAG_OFF);
    if (SB) { if (tid < 8) flags[tid] = 0; }
    const int qglob = qrow0 + r32;
    for (int it = 0; it < ntiles; ++it) {
        const int j = SB ? (ntiles - 1 - it) : it;
        const int kv0 = j * 64;
        __syncthreads();
        if (SB) { bool alldead = true;
#pragma unroll
            for (int w = 0; w < 8; ++w) alldead = alldead && (flags[w] != 0);
            if (alldead) break; }
        for (int c = tid; c < 64 * KCH; c += NWAVES * 64) { const int row = c / KCH, ch = c - row * KCH;
            const v4u v = *(const v4u*)(Kp + (size_t)(kv0 + row) * kpitch + ch * 8); *(LAS v4u*)(lds + KS_OFF + row * KROW + ch * 16) = v; }
        { const int row = tid >> 3, ch = tid & 7; const v4u v = *(const v4u*)(Vp + (size_t)(kv0 + row) * vpitch + ch * 8);
            LAS unsigned short* vt = (LAS unsigned short*)(lds + VT_OFF) + (ch * 8) * (VROW / 2) + row;
            vt[0 * (VROW / 2)] = (unsigned short)(v.x & 0xffffu); vt[1 * (VROW / 2)] = (unsigned short)(v.x >> 16);
            vt[2 * (VROW / 2)] = (unsigned short)(v.y & 0xffffu); vt[3 * (VROW / 2)] = (unsigned short)(v.y >> 16);
            vt[4 * (VROW / 2)] = (unsigned short)(v.z & 0xffffu); vt[5 * (VROW / 2)] = (unsigned short)(v.z >> 16);
            vt[6 * (VROW / 2)] = (unsigned short)(v.w & 0xffffu); vt[7 * (VROW / 2)] = (unsigned short)(v.w >> 16); }
        __syncthreads();
        if (kv0 > qrow0 + 31) continue;
        f32x16 p0, p1;
#pragma unroll
        for (int r = 0; r < 16; ++r) { p0[r] = 0.f; p1[r] = 0.f; }
#pragma unroll
        for (int ks = 0; ks < NKS; ++ks) {
            const bf16x8 a0 = *(const LAS bf16x8*)(lds + KS_OFF + r32 * KROW + ks * 32 + hi * 16);
            const bf16x8 a1 = *(const LAS bf16x8*)(lds + KS_OFF + (32 + r32) * KROW + ks * 32 + hi * 16);
            p0 = __builtin_amdgcn_mfma_f32_32x32x16_bf16(a0, qr[ks], p0, 0, 0, 0);
            p1 = __builtin_amdgcn_mfma_f32_32x32x16_bf16(a1, qr[ks], p1, 0, 0, 0);
        }
        const bool diag = (kv0 + 63 >= qrow0);
        if (!SB) {
            if (diag) {
#pragma unroll
                for (int r = 0; r < 16; ++r) { const int kv = kv0 + crow(r, hi); if (kv > qglob) p0[r] = -INFINITY; if (kv + 32 > qglob) p1[r] = -INFINITY; }
            }
            float rm = fmaxf(p0[0], p1[0]);
#pragma unroll
            for (int r = 1; r < 16; ++r) rm = fmaxf(rm, fmaxf(p0[r], p1[r]));
            rm = fmaxf(rm, __shfl_xor(rm, 32));
            const float m_new = fmaxf(m_run, rm);
            const float f = __builtin_amdgcn_exp2f(m_run - m_new);
            m_run = m_new;
            float rs = 0.f;
#pragma unroll
            for (int r = 0; r < 16; ++r) { p0[r] = __builtin_amdgcn_exp2f(p0[r] - m_new); p1[r] = __builtin_amdgcn_exp2f(p1[r] - m_new); rs += p0[r] + p1[r]; }
            l_run = l_run * f + rs;
#pragma unroll
            for (int r = 0; r < 16; ++r) { o0[r] *= f; o1[r] *= f; }
        } else {
            f32x16 L0, L1;
#pragma unroll
            for (int r = 0; r < 16; ++r) {
                const float z0 = p0[r] * 0.125f, z1 = p1[r] * 0.125f;
                const float s0 = fmaxf(z0, 0.f) + __logf(1.0f + __expf(-fabsf(z0))), s1 = fmaxf(z1, 0.f) + __logf(1.0f + __expf(-fabsf(z1)));
                const int kv = kv0 + crow(r, hi);
                const bool v0 = !diag || (kv < qglob), v1 = !diag || (kv + 32 < qglob);
                p0[r] = v0 ? z0 : -INFINITY; p1[r] = v1 ? z1 : -INFINITY;
                L0[r] = v0 ? -s0 : 0.f; L1[r] = v1 ? -s1 : 0.f;
            }
            float gs[8], gp[8], tot[8], suf[8];
#pragma unroll
            for (int g = 0; g < 4; ++g) { gs[g] = (L0[4 * g] + L0[4 * g + 1]) + (L0[4 * g + 2] + L0[4 * g + 3]); gs[4 + g] = (L1[4 * g] + L1[4 * g + 1]) + (L1[4 * g + 2] + L1[4 * g + 3]); }
#pragma unroll
            for (int g = 0; g < 8; ++g) { gp[g] = __shfl_xor(gs[g], 32); tot[g] = gs[g] + gp[g]; }
            suf[7] = 0.f;
#pragma unroll
            for (int g = 6; g >= 0; --g) suf[g] = suf[g + 1] + tot[g + 1];
#pragma unroll
            for (int g = 0; g < 8; ++g) {
                const float E = suf[g] + (hi == 0 ? gp[g] : 0.f) + A;
                if (g < 4) { const float c3 = L0[4 * g + 3] + E, c2 = L0[4 * g + 2] + c3, c1 = L0[4 * g + 1] + c2, c0 = L0[4 * g] + c1;
                    p0[4 * g] = __expf(p0[4 * g] + c0); p0[4 * g + 1] = __expf(p0[4 * g + 1] + c1); p0[4 * g + 2] = __expf(p0[4 * g + 2] + c2); p0[4 * g + 3] = __expf(p0[4 * g + 3] + c3); }
                else { const int q = g - 4; const float c3 = L1[4 * q + 3] + E, c2 = L1[4 * q + 2] + c3, c1 = L1[4 * q + 1] + c2, c0 = L1[4 * q] + c1;
                    p1[4 * q] = __expf(p1[4 * q] + c0); p1[4 * q + 1] = __expf(p1[4 * q + 1] + c1); p1[4 * q + 2] = __expf(p1[4 * q + 2] + c2); p1[4 * q + 3] = __expf(p1[4 * q + 3] + c3); }
            }
            A = A + (suf[0] + tot[0]);
            const bool dead = __all(A < -104.0f);
            if (lane == 0) flags[wid] = dead ? 1 : 0;
        }
        bf16x8 pw[4];
        { v4u t;
          t.x = pk2(p0[0], p0[1]); t.y = pk2(p0[2], p0[3]); t.z = pk2(p0[4], p0[5]); t.w = pk2(p0[6], p0[7]); pw[0] = __builtin_bit_cast(bf16x8, t);
          t.x = pk2(p0[8], p0[9]); t.y = pk2(p0[10], p0[11]); t.z = pk2(p0[12], p0[13]); t.w = pk2(p0[14], p0[15]); pw[1] = __builtin_bit_cast(bf16x8, t);
          t.x = pk2(p1[0], p1[1]); t.y = pk2(p1[2], p1[3]); t.z = pk2(p1[4], p1[5]); t.w = pk2(p1[6], p1[7]); pw[2] = __builtin_bit_cast(bf16x8, t);
          t.x = pk2(p1[8], p1[9]); t.y = pk2(p1[10], p1[11]); t.z = pk2(p1[12], p1[13]); t.w = pk2(p1[14], p1[15]); pw[3] = __builtin_bit_cast(bf16x8, t); }
#pragma unroll
        for (int ks = 0; ks < 4; ++ks) {
            const LAS unsigned char* vb = lds + VT_OFF + (16 * ks + 4 * hi) * 2;
            const v2u a0l = *(const LAS v2u*)(vb + r32 * VROW), a0h = *(const LAS v2u*)(vb + r32 * VROW + 16);
            const v2u a1l = *(const LAS v2u*)(vb + (32 + r32) * VROW), a1h = *(const LAS v2u*)(vb + (32 + r32) * VROW + 16);
            const v4u a0 = {a0l.x, a0l.y, a0h.x, a0h.y}, a1 = {a1l.x, a1l.y, a1h.x, a1h.y};
            o0 = __builtin_amdgcn_mfma_f32_32x32x16_bf16(__builtin_bit_cast(bf16x8, a0), pw[ks], o0, 0, 0, 0);
            o1 = __builtin_amdgcn_mfma_f32_32x32x16_bf16(__builtin_bit_cast(bf16x8, a1), pw[ks], o1, 0, 0, 0);
        }
    }
    float inv = 1.0f;
    if (!SB) { const float lt = l_run + __shfl_xor(l_run, 32); inv = 1.0f / lt; }
    bf16* orow = Op + (size_t)(qrow0 + r32) * opitch;
#pragma unroll
    for (int g = 0; g < 4; ++g) {
        v2u w0, w1;
        w0.x = pk2(o0[4 * g] * inv, o0[4 * g + 1] * inv); w0.y = pk2(o0[4 * g + 2] * inv, o0[4 * g + 3] * inv);
        w1.x = pk2(o1[4 * g] * inv, o1[4 * g + 1] * inv); w1.y = pk2(o1[4 * g + 2] * inv, o1[4 * g + 3] * inv);
        *(v2u*)(orow + 8 * g + 4 * hi) = w0; *(v2u*)(orow + 32 + 8 * g + 4 * hi) = w1;
    }
    __syncthreads();
}
constexpr int NPH = 23;
#ifndef MK_PER_PHASE
#define MK_PER_PHASE 0
#endif
#ifndef PROBE_MASK
#define PROBE_MASK 0
#endif
#define NREP(k) (1 + ((PROBE_MASK >> (k)) & 1))
struct Args { const float* in[30]; float* out; unsigned char* ws; int ph_lo, ph_hi; };
__device__ const double kInvFreq4[4] = {1.0, 0.5623413251903491, 0.31622776601683794, 0.1778279410038923};

__global__ void __launch_bounds__(NWAVES * 64, 2) fwd(Args args) {
    extern __shared__ __attribute__((aligned(16))) unsigned char lds_raw[];
    LAS unsigned char* lds = (LAS unsigned char*)lds_raw;
    volatile LAS unsigned* MISC = (volatile LAS unsigned*)(lds + MISC_OFF);
    const int tid = threadIdx.x, lane = tid & 63, wave = __builtin_amdgcn_readfirstlane(tid >> 6);
    const int G = gridDim.x, bx = blockIdx.x;
    const int vcu = (G % 8 == 0) ? (bx % 8) * (G / 8) + bx / 8 : bx;
    const int gw = vcu * NWAVES + wave, NGW = G * NWAVES;
    unsigned char* ws = args.ws;
    gu32* ctl = (gu32*)(ws + WS_CTL);
    float* out = args.out;
    for (int u = tid; u < (LDS_BYTES - LDSCTL_OFF) / 4; u += NWAVES * 64) ((LAS unsigned*)(lds + LDSCTL_OFF))[u] = 0u;
    __syncthreads();
    XcdBarrier bar; bar.bar = (unsigned*)(ctl + CW_BAR); bar.x = 0; bar.st = nullptr;
    if (!MK_PER_PHASE) bar = xcd_barrier_post((unsigned*)(ctl + CW_BAR), MISC + 8);
#define GRID_BAR() do { if (!MK_PER_PHASE) xcd_barrier(bar); } while (0)
    const int lo = args.ph_lo, hi_ph = args.ph_hi;
#define IN(k) (lo <= (k) && (k) < hi_ph)
#define BOTH(k) (IN(k) && IN((k) + 1))

    bf16* Win_t = (bf16*)(ws + WS_WIN); bf16* Wqup_t = (bf16*)(ws + WS_WQUP); bf16* Wkvup_t = (bf16*)(ws + WS_WKVUP); bf16* Wout_t = (bf16*)(ws + WS_WOUT);
    bf16* Wdgu_t = (bf16*)(ws + WS_WDGU); bf16* Wddn_t = (bf16*)(ws + WS_WDDN); bf16* Wsin_t = (bf16*)(ws + WS_WSIN); bf16* Wglu_t = (bf16*)(ws + WS_WGLU);
    bf16* Mgu_t = (bf16*)(ws + WS_MGU); bf16* Mdn_t = (bf16*)(ws + WS_MDN);
    bf16* XN = (bf16*)(ws + WS_XN); bf16* Hb = (bf16*)(ws + WS_H); bf16* QRAW = (bf16*)(ws + WS_QRAW); bf16* KVRAW = (bf16*)(ws + WS_KVRAW);
    bf16* QM = (bf16*)(ws + WS_QM); bf16* KM = (bf16*)(ws + WS_KM); bf16* MERGED = (bf16*)(ws + WS_MERGED); bf16* CQ = (bf16*)(ws + WS_CQ); bf16* CKV = (bf16*)(ws + WS_CKV);
    bf16* DACT = (bf16*)(ws + WS_DACT); float* Ub = (float*)(ws + WS_U); float* HEND = (float*)(ws + WS_HEND); bf16* Yb = (bf16*)(ws + WS_Y);
    bf16* XS = (bf16*)(ws + WS_XS); bf16* MACT = (bf16*)(ws + WS_MACT); int* LTOK = (int*)(ws + WS_LTOK); float* LW = (float*)(ws + WS_LW);
    int* STOK = (int*)(ws + WS_STOK); float* SWT = (float*)(ws + WS_SW); int* TILEE = (int*)(ws + WS_TILEE);
    float* ROPE = (float*)(ws + WS_ROPE); float* STAB = (float*)(ws + WS_STAB);

    if (IN(0)) for (int rep = 0; rep < NREP(0); ++rep) {
        LAS float* scr = (LAS float*)(lds + RING_OFF + wave * 16384);
        constexpr int I_IN = 16 * 61, I_QU = 4 * 24, I_KVU = 2 * 32, I_OUT = 16 * 32, I_DG = 16 * 112, I_DD = 56 * 32, I_SIN = 16 * 16, I_GLU = 8 * 64;
        constexpr int NIT = I_IN + I_QU + I_KVU + I_OUT + 2 * I_DG + I_DD + I_SIN + I_GLU;
        for (int it = gw; it < NIT; it += NGW) {
            int r = it;
            if (r < I_IN) { const int kb = r / 61, nb = r % 61; transpose_item(args.in[2], INC, 64 * kb, 32 * nb, Win_t + (size_t)(32 * nb) * 1024 + 64 * kb, 1024, scr, lane); continue; } r -= I_IN;
            if (r < I_QU) { const int kb = r / 24, nb = r % 24; transpose_item(args.in[4], 768, 64 * kb, 32 * nb, Wqup_t + (size_t)(32 * nb) * 256 + 64 * kb, 256, scr, lane); continue; } r -= I_QU;
            if (r < I_KVU) { const int kb = r / 32, nb = r % 32; transpose_item(args.in[6], 1024, 64 * kb, 32 * nb, Wkvup_t + (size_t)(32 * nb) * 128 + 64 * kb, 128, scr, lane); continue; } r -= I_KVU;
            if (r < I_OUT) { const int kb = r / 32, nb = r % 32; transpose_item(args.in[9], 1024, 64 * kb, 32 * nb, Wout_t + (size_t)(32 * nb) * 1024 + 64 * kb, 1024, scr, lane); continue; } r -= I_OUT;
            if (r < 2 * I_DG) { const int which = r / I_DG, rr = r % I_DG, kb = rr / 112, nb = rr % 112, n0 = 32 * nb; const int drow = 256 * (n0 / 128) + 128 * which + (n0 % 128);
                transpose_item(args.in[11 + which], FF, 64 * kb, n0, Wdgu_t + (size_t)drow * 1024 + 64 * kb, 1024, scr, lane); continue; } r -= 2 * I_DG;
            if (r < I_DD) { const int kb = r / 32, nb = r % 32; transpose_item(args.in[13], 1024, 64 * kb, 32 * nb, Wddn_t + (size_t)(32 * nb) * FF + 64 * kb, FF, scr, lane); continue; } r -= I_DD;
            if (r < I_SIN) { const int kb = r / 16, nb = r % 16; transpose_item(args.in[15], SW, 64 * kb, 32 * nb, Wsin_t + (size_t)(32 * nb) * 1024 + 64 * kb, 1024, scr, lane); continue; } r -= I_SIN;
            { const int kb = r / 64, nb = r % 64, n0 = 32 * nb; const int nn = n0 & 1023; const int drow = 256 * (nn / 128) + 128 * (n0 >> 10) + (nn % 128);
                transpose_item(args.in[24], 2048, 64 * kb, n0, Wglu_t + (size_t)drow * SW + 64 * kb, SW, scr, lane); }
        }
        for (int i = bx * (NWAVES * 64) + tid; i < 96 * 128; i += G * NWAVES * 64) ((v4u*)(Win_t + (size_t)INC * 1024))[i] = (v4u){0u, 0u, 0u, 0u};
        for (int i = bx * (NWAVES * 64) + tid; i < SEQ * 16; i += G * NWAVES * 64) {
            const int t = i >> 4, f = i & 15; double inv = kInvFreq4[f & 3]; const int dec = f >> 2; if (dec >= 1) inv *= 0.1; if (dec >= 2) inv *= 0.1; if (dec >= 3) inv *= 0.1;
            const double rev = (double)t * (double)(float)inv * 0.15915494309189535; const double fr = rev - __builtin_rint(rev);
            ROPE[2 * i] = __builtin_amdgcn_cosf((float)fr); ROPE[2 * i + 1] = __builtin_amdgcn_sinf((float)fr);
        }
        for (int i = bx * (NWAVES * 64) + tid; i < 32 * 64; i += G * NWAVES * 64) {
            const int g = i >> 6, n = i & 63;
            double are = (double)args.in[16][i]; if (are > -1e-4) are = -1e-4; const double aim = (double)args.in[17][i];
            const double dt = exp((double)args.in[18][g]);
            const double mag = exp(are * dt), lre = mag * cos(aim * dt), lim = mag * sin(aim * dt);
            const double den = are * are + aim * aim, nre = lre - 1.0;
            const double cre = (nre * are + lim * aim) / den, cim = (lim * are - nre * aim) / den;
            const double magL = exp(are * dt * CH), lLre = magL * cos(aim * dt * CH), lLim = magL * sin(aim * dt * CH);
            float* tb = STAB + (size_t)g * 36 * 64 + n;
            tb[0 * 64] = (float)lre; tb[1 * 64] = (float)lim; tb[2 * 64] = (float)lLre; tb[3 * 64] = (float)lLim;
            for (int c = 0; c < 16; ++c) { const double bre = (double)args.in[19][(size_t)i * 16 + c], bim = (double)args.in[20][(size_t)i * 16 + c];
                tb[(4 + c) * 64] = (float)(cre * bre - cim * bim); tb[(20 + c) * 64] = (float)(cre * bim + cim * bre); }
        }
        for (int m = gw; m < M; m += NGW) rms_row_to_bf16(args.in[0] + (size_t)m * D, args.in[1], XN + (size_t)m * D, lane);
        if (BOTH(0) || rep + 1 < NREP(0)) GRID_BAR();
    }
    if (IN(1)) for (int rep = 0; rep < NREP(1); ++rep) {
        pg8::Gemm g{XN, Win_t, M, INP, D}; pg8::StaticOrder S; S.init(M, INP, G, bx);
        pg8::EpiBf16Plain E{Hb, INP};
        pg8::gemm_phase<pg8::EpiBf16Plain, pg8::StaticOrder, true, true>(lds + RING_OFF, g, S, E);
        if (BOTH(1) || rep + 1 < NREP(1)) GRID_BAR();
    }
    if (IN(2)) for (int rep = 0; rep < NREP(2); ++rep) {
        const float* gq = args.in[3]; const float* gkv = args.in[5];
        for (int m = gw; m < M; m += NGW) {
            const bf16* hr = Hb + (size_t)m * INP;
            { const v2u raw = *(const v2u*)(hr + 1536 + 4 * lane); const float a = bflo(raw.x), b = bfhi(raw.x), c = bflo(raw.y), d = bfhi(raw.y);
              const float rstd = 1.0f / sqrtf(wave_sum((a * a + b * b) + (c * c + d * d)) * (1.f / 256.f) + EPS); const f32x4 gg = *(const f32x4*)(gq + 4 * lane);
              v2u o; o.x = pk2(a * rstd * gg.x, b * rstd * gg.y); o.y = pk2(c * rstd * gg.z, d * rstd * gg.w); *(v2u*)(CQ + (size_t)m * 256 + 4 * lane) = o; }
            { const unsigned raw = *(const unsigned*)(hr + 1792 + 2 * lane); const float a = bflo(raw), b = bfhi(raw);
              const float rstd = 1.0f / sqrtf(wave_sum(a * a + b * b) * (1.f / 128.f) + EPS);
              *(unsigned*)(CKV + (size_t)m * 128 + 2 * lane) = pk2(a * rstd * gkv[2 * lane], b * rstd * gkv[2 * lane + 1]); }
        }
        if (BOTH(2) || rep + 1 < NREP(2)) GRID_BAR();
    }
    if (IN(3)) for (int rep = 0; rep < NREP(3); ++rep) {
        pg8::Gemm g{CQ, Wqup_t, M, 768, 256}; pg8::StaticOrder S; S.init(M, 768, G, bx);
        pg8::EpiBf16Plain E{QRAW, 768};
        pg8::gemm_phase<pg8::EpiBf16Plain, pg8::StaticOrder, true, true>(lds + RING_OFF, g, S, E);
        if (BOTH(3) || rep + 1 < NREP(3)) GRID_BAR();
    }
    if (IN(4)) for (int rep = 0; rep < NREP(4); ++rep) {
        pg8::Gemm g{CKV, Wkvup_t, M, 1024, 128}; pg8::StaticOrder S; S.init(M, 1024, G, bx);
        pg8::EpiBf16Plain E{KVRAW, 1024};
        pg8::gemm_phase<pg8::EpiBf16Plain, pg8::StaticOrder, true, true>(lds + RING_OFF, g, S, E);
        if (BOTH(4) || rep + 1 < NREP(4)) GRID_BAR();
    }
    if (IN(5)) for (int rep = 0; rep < NREP(5); ++rep) {
        const float* qg = args.in[7]; const float* kg = args.in[8];
        constexpr float QSCALE = 0.10206207261596575f * 1.4426950408889634f;
        for (int idx = bx * (NWAVES * 64) + tid; idx < M * 8; idx += G * NWAVES * 64) {
            const int m = idx >> 3, h = idx & 7, t = m & (SEQ - 1);
            const f32x4* rp = (const f32x4*)(ROPE + (size_t)t * 32);
            float cs[16], sn[16];
#pragma unroll
            for (int i = 0; i < 8; ++i) { const f32x4 v = rp[i]; cs[2 * i] = v.x; sn[2 * i] = v.y; cs[2 * i + 1] = v.z; sn[2 * i + 1] = v.w; }
#pragma unroll
            for (int which = 0; which < 2; ++which) {
                v4u ch[12];
                if (which == 0) {
                    const v4u* src = (const v4u*)(QRAW + (size_t)m * 768 + h * 96);
#pragma unroll
                    for (int c = 0; c < 12; ++c) ch[c] = src[c];
                } else {
                    const v4u* s1 = (const v4u*)(KVRAW + (size_t)m * 1024 + h * 128); const v4u* s2 = (const v4u*)(Hb + (size_t)m * INP + 1920);
#pragma unroll
                    for (int c = 0; c < 8; ++c) ch[c] = s1[c];
#pragma unroll
                    for (int c = 0; c < 4; ++c) ch[8 + c] = s2[c];
                }
                float ss = 0.f;
#pragma unroll
                for (int c = 0; c < 12; ++c) { const v4u v = ch[c]; const float a0 = bflo(v.x), a1 = bfhi(v.x), a2 = bflo(v.y), a3 = bfhi(v.y), a4 = bflo(v.z), a5 = bfhi(v.z), a6 = bflo(v.w), a7 = bfhi(v.w);
                    ss += ((a0 * a0 + a1 * a1) + (a2 * a2 + a3 * a3)) + ((a4 * a4 + a5 * a5) + (a6 * a6 + a7 * a7)); }
                const float rstd = 1.0f / sqrtf(ss * (1.f / 96.f) + EPS);
                const float osc = which == 0 ? QSCALE : 1.0f;
                const float* gn = which == 0 ? qg : kg;
                bf16* dst = (which == 0 ? QM : KM) + (size_t)m * 768 + h * 96;
#pragma unroll
                for (int c = 0; c < 8; ++c) { const v4u v = ch[c]; float a[8] = {bflo(v.x), bfhi(v.x), bflo(v.y), bfhi(v.y), bflo(v.z), bfhi(v.z), bflo(v.w), bfhi(v.w)};
#pragma unroll
                    for (int e = 0; e < 8; ++e) a[e] = a[e] * rstd * gn[8 * c + e] * osc;
                    v4u o; o.x = pk2(a[0], a[1]); o.y = pk2(a[2], a[3]); o.z = pk2(a[4], a[5]); o.w = pk2(a[6], a[7]); ((v4u*)dst)[c] = o; }
#pragma unroll
                for (int c = 0; c < 2; ++c) { const v4u v1 = ch[8 + c], v2 = ch[10 + c];
                    float a[8] = {bflo(v1.x), bfhi(v1.x), bflo(v1.y), bfhi(v1.y), bflo(v1.z), bfhi(v1.z), bflo(v1.w), bfhi(v1.w)};
                    float b[8] = {bflo(v2.x), bfhi(v2.x), bflo(v2.y), bfhi(v2.y), bflo(v2.z), bfhi(v2.z), bflo(v2.w), bfhi(v2.w)};
                    float ra[8], rb[8];
#pragma unroll
                    for (int e = 0; e < 8; ++e) { const float r1 = a[e] * rstd * gn[64 + 8 * c + e], r2 = b[e] * rstd * gn[80 + 8 * c + e]; const float co = cs[8 * c + e], si = sn[8 * c + e];
                        ra[e] = (r1 * co - r2 * si) * osc; rb[e] = (r2 * co + r1 * si) * osc; }
                    v4u o1, o2; o1.x = pk2(ra[0], ra[1]); o1.y = pk2(ra[2], ra[3]); o1.z = pk2(ra[4], ra[5]); o1.w = pk2(ra[6], ra[7]);
                    o2.x = pk2(rb[0], rb[1]); o2.y = pk2(rb[2], rb[3]); o2.z = pk2(rb[4], rb[5]); o2.w = pk2(rb[6], rb[7]);
                    ((v4u*)dst)[8 + c] = o1; ((v4u*)dst)[10 + c] = o2; }
            }
        }
        if (BOTH(5) || rep + 1 < NREP(5)) GRID_BAR();
    }
    if (IN(6)) for (int rep = 0; rep < NREP(6); ++rep) {
        for (;;) {
            __syncthreads();
            if (tid == 0) MISC[0] = __hip_atomic_fetch_add(ctl + CW_QUEUE + rep, 1u, RLX_AGENT);
            __syncthreads();
            const int idx = (int)MISC[0];
            if (idx >= 1024) break;
            const int qb = 31 - (idx >> 5), r = idx & 31, kind = r >> 4, bh = r & 15, b = bh >> 3, h = bh & 7;
            const size_t rb = (size_t)b * SEQ;
            if (kind == 0) attn_unit<96, false>(lds, QM + rb * 768 + h * 96, 768, KM + rb * 768 + h * 96, 768, KVRAW + rb * 1024 + h * 128 + 64, 1024, MERGED + rb * 1024 + 512 + h * 64, 1024, qb, tid, wave, lane);
            else attn_unit<64, true>(lds, Hb + rb * INP + h * 64, INP, Hb + rb * INP + 512 + h * 64, INP, Hb + rb * INP + 1024 + h * 64, INP, MERGED + rb * 1024 + h * 64, 1024, qb, tid, wave, lane);
        }
        if (BOTH(6) || rep + 1 < NREP(6)) GRID_BAR();
    }
    if (IN(7)) for (int rep = 0; rep < NREP(7); ++rep) {
        pg8::Gemm g{MERGED, Wout_t, M, D, D}; pg8::StaticOrder S; S.init(M, D, G, bx);
        pg8::EpiResF32 E{args.in[0], out, D, 1.0f};
        pg8::gemm_phase<pg8::EpiResF32, pg8::StaticOrder, true, true>(lds + RING_OFF, g, S, E);
        if (BOTH(7) || rep + 1 < NREP(7)) GRID_BAR();
    }
    if (IN(8)) for (int rep = 0; rep < NREP(8); ++rep) {
        for (int m = gw; m < M; m += NGW) rms_row_to_bf16(out + (size_t)m * D, args.in[10], XN + (size_t)m * D, lane);
        if (BOTH(8) || rep + 1 < NREP(8)) GRID_BAR();
    }
    if (IN(9)) for (int rep = 0; rep < NREP(9); ++rep) {
        pg8::Gemm g{XN, Wdgu_t, M, 2 * FF, D}; pg8::StaticOrder S; S.init(M, 2 * FF, G, bx);
        pg8::EpiSwiGLU E{DACT, FF, 28, 0};
        pg8::gemm_phase<pg8::EpiSwiGLU, pg8::StaticOrder, true, true>(lds + RING_OFF, g, S, E);
        if (BOTH(9) || rep + 1 < NREP(9)) GRID_BAR();
    }
    if (IN(10)) for (int rep = 0; rep < NREP(10); ++rep) {
        pg8::Gemm g{DACT, Wddn_t, M, D, FF}; pg8::StaticOrder S; S.init(M, D, G, bx);
        pg8::EpiResF32 E{out, out, D, rep ? 0.0f : 1.0f};
        pg8::gemm_phase<pg8::EpiResF32, pg8::StaticOrder, true, true>(lds + RING_OFF, g, S, E);
        if (BOTH(10) || rep + 1 < NREP(10)) GRID_BAR();
    }
    if (IN(11)) for (int rep = 0; rep < NREP(11); ++rep) {
        for (int m = gw; m < M; m += NGW) rms_row_to_bf16(out + (size_t)m * D, args.in[14], XN + (size_t)m * D, lane);
        LAS float* scr = (LAS float*)(lds + RING_OFF + wave * 16384);
        constexpr int I_G = 16 * 112, I_GU = NE * 2 * I_G, I_DN = NE * 56 * 32;
        for (int it = gw; it < I_GU + I_DN; it += NGW) {
            if (it < I_GU) { const int e = it / (2 * I_G), r1 = it % (2 * I_G), which = r1 / I_G, rr = r1 % I_G, kb = rr / 112, nb = rr % 112, n0 = 32 * nb;
                const int drow = e * 2 * FF + 256 * (n0 / 128) + 128 * which + (n0 % 128);
                transpose_item(args.in[27 + which] + (size_t)e * D * FF, FF, 64 * kb, n0, Mgu_t + (size_t)drow * 1024 + 64 * kb, 1024, scr, lane); }
            else { const int r = it - I_GU, e = r / (56 * 32), rr = r % (56 * 32), kb = rr / 32, nb = rr % 32, k0 = 64 * kb, p = k0 / FFH;
                transpose_item(args.in[29] + (size_t)e * FF * D, D, k0, 32 * nb, Mdn_t + (size_t)p * (NE * 1024) * FFH + (size_t)(e * 1024 + 32 * nb) * FFH + (k0 - p * FFH), FFH, scr, lane); }
        }
        if (BOTH(11) || rep + 1 < NREP(11)) GRID_BAR();
    }
    if (IN(12)) for (int rep = 0; rep < NREP(12); ++rep) {
        pg8::Gemm g{XN, Wsin_t, M, SW, D}; pg8::StaticOrder S; S.init(M, SW, G, bx);
        pg8::EpiResF32 E{nullptr, Ub, SW, 1.0f};
        pg8::gemm_phase<pg8::EpiResF32, pg8::StaticOrder, true, true>(lds + RING_OFF, g, S, E);
        if (BOTH(12) || rep + 1 < NREP(12)) GRID_BAR();
    }
    if (IN(13)) for (int rep = 0; rep < NREP(13); ++rep) {
        LAS float* us = (LAS float*)(lds + RING_OFF + wave * 8192);
        for (int item = gw; item < NB * 32 * NCH; item += NGW) {
            const int b = item / (32 * NCH), g = (item / NCH) % 32, c = item % NCH;
            const float* tb = STAB + (size_t)g * 36 * 64 + lane;
            const float lre = tb[0], lim = tb[64]; float bre[16], bim[16];
#pragma unroll
            for (int k = 0; k < 16; ++k) { bre[k] = tb[(4 + k) * 64]; bim[k] = tb[(20 + k) * 64]; }
            const size_t m0 = (size_t)b * SEQ + (size_t)c * CH;
#pragma unroll
            for (int i = 0; i < 8; ++i) { const int e = lane + 64 * i, row = e >> 2, q = e & 3; *(LAS f32x4*)(us + row * 16 + 4 * q) = *(const f32x4*)(Ub + (m0 + row) * SW + 16 * g + 4 * q); }
            LDS_WAIT(); asm volatile("" ::: "memory");
            float hr = 0.f, hi2 = 0.f;
#pragma unroll 4
            for (int t = 0; t < CH; ++t) {
                float ur = 0.f, ui = 0.f;
#pragma unroll
                for (int q = 0; q < 4; ++q) { const f32x4 uv = *(const LAS f32x4*)(us + t * 16 + 4 * q);
                    ur += bre[4 * q] * uv.x + bre[4 * q + 1] * uv.y + bre[4 * q + 2] * uv.z + bre[4 * q + 3] * uv.w;
                    ui += bim[4 * q] * uv.x + bim[4 * q + 1] * uv.y + bim[4 * q + 2] * uv.z + bim[4 * q + 3] * uv.w; }
                const float nr = lre * hr - lim * hi2 + ur, ni = lre * hi2 + lim * hr + ui; hr = nr; hi2 = ni;
            }
            *(f32x2*)(HEND + ((size_t)item * 64 + lane) * 2) = (f32x2){hr, hi2};
            LDS_WAIT(); asm volatile("" ::: "memory");
        }
        if (BOTH(13) || rep + 1 < NREP(13)) GRID_BAR();
    }
    if (IN(14)) for (int rep = 0; rep < NREP(14); ++rep) {
        LAS float* us = (LAS float*)(lds + RING_OFF + wave * 8192);
        LAS unsigned char* hs = lds + RING_OFF + 65536 + wave * 4352;
        const float* cre_p = args.in[21]; const float* cim_p = args.in[22]; const float* dsk_p = args.in[23];
        const int cc = lane & 15, kq = lane >> 4;
        for (int item = gw; item < NB * 32 * NCH; item += NGW) {
            const int b = item / (32 * NCH), g = (item / NCH) % 32, c = item % NCH;
            const float* tb = STAB + (size_t)g * 36 * 64 + lane;
            const float lre = tb[0], lim = tb[64], lLre = tb[128], lLim = tb[192]; float bre[16], bim[16];
#pragma unroll
            for (int k = 0; k < 16; ++k) { bre[k] = tb[(4 + k) * 64]; bim[k] = tb[(20 + k) * 64]; }
            bf16x8 cm[4];
#pragma unroll
            for (int ks = 0; ks < 4; ++ks) { const int k0 = 32 * ks + 8 * kq; const float* src = (ks < 2 ? cre_p : cim_p) + ((size_t)(g * 16 + cc) * 64 + (k0 & 63)); const float sg = ks < 2 ? 1.f : -1.f;
                const f32x4 a = *(const f32x4*)src, bq = *(const f32x4*)(src + 4);
                v4u t; t.x = pk2(sg * a.x, sg * a.y); t.y = pk2(sg * a.z, sg * a.w); t.z = pk2(sg * bq.x, sg * bq.y); t.w = pk2(sg * bq.z, sg * bq.w); cm[ks] = __builtin_bit_cast(bf16x8, t); }
            const float dsk = dsk_p[16 * g + cc];
            float hr = 0.f, hi2 = 0.f;
            { const float* he = HEND + ((size_t)(item - c) * 64 + lane) * 2;
              for (int c2 = 0; c2 < c; ++c2) { const f32x2 e = *(const f32x2*)(he + (size_t)c2 * 128); const float nr = lLre * hr - lLim * hi2 + e.x, ni = lLre * hi2 + lLim * hr + e.y; hr = nr; hi2 = ni; } }
            const size_t m0 = (size_t)b * SEQ + (size_t)c * CH;
#pragma unroll
            for (int i = 0; i < 8; ++i) { const int e = lane + 64 * i, row = e >> 2, q = e & 3; *(LAS f32x4*)(us + row * 16 + 4 * q) = *(const f32x4*)(Ub + (m0 + row) * SW + 16 * g + 4 * q); }
            LDS_WAIT(); asm volatile("" ::: "memory");
            for (int tb16 = 0; tb16 < CH / 16; ++tb16) {
#pragma unroll 4
                for (int tt = 0; tt < 16; ++tt) {
                    const int t = tb16 * 16 + tt;
                    float ur = 0.f, ui = 0.f;
#pragma unroll
                    for (int q = 0; q < 4; ++q) { const f32x4 uv = *(const LAS f32x4*)(us + t * 16 + 4 * q);
                        ur += bre[4 * q] * uv.x + bre[4 * q + 1] * uv.y + bre[4 * q + 2] * uv.z + bre[4 * q + 3] * uv.w;
                        ui += bim[4 * q] * uv.x + bim[4 * q + 1] * uv.y + bim[4 * q + 2] * uv.z + bim[4 * q + 3] * uv.w; }
                    const float nr = lre * hr - lim * hi2 + ur, ni = lre * hi2 + lim * hr + ui; hr = nr; hi2 = ni;
                    *(LAS unsigned short*)(hs + tt * 272 + lane * 2) = (unsigned short)f2bf(hr);
                    *(LAS unsigned short*)(hs + tt * 272 + 128 + lane * 2) = (unsigned short)f2bf(hi2);
                }
                LDS_WAIT(); asm volatile("" ::: "memory");
                f32x4 acc = {0.f, 0.f, 0.f, 0.f};
#pragma unroll
                for (int ks = 0; ks < 4; ++ks) { const bf16x8 a = *(const LAS bf16x8*)(hs + cc * 272 + (32 * ks + 8 * kq) * 2); acc = __builtin_amdgcn_mfma_f32_16x16x32_bf16(a, cm[ks], acc, 0, 0, 0); }
#pragma unroll
                for (int jj = 0; jj < 4; ++jj) { const int t = tb16 * 16 + 4 * kq + jj; const float uu = us[t * 16 + cc]; const float yv = gelu_tanh(acc[jj] + dsk * uu);
                    Yb[(m0 + t) * SW + 16 * g + cc] = (bf16)f2bf(yv); }
                LDS_WAIT(); asm volatile("" ::: "memory");
            }
        }
        if (BOTH(14) || rep + 1 < NREP(14)) GRID_BAR();
    }
    if (IN(15)) for (int rep = 0; rep < NREP(15); ++rep) {
        pg8::Gemm g{Yb, Wglu_t, M, 2048, SW}; pg8::StaticOrder S; S.init(M, 2048, G, bx);
        pg8::EpiGLU E{out, D, rep ? 0.0f : 1.0f};
        pg8::gemm_phase<pg8::EpiGLU, pg8::StaticOrder, true, true>(lds + RING_OFF, g, S, E);
        if (BOTH(15) || rep + 1 < NREP(15)) GRID_BAR();
    }
    if (IN(16)) for (int rep = 0; rep < NREP(16); ++rep) {
        LAS float* rt = (LAS float*)(lds + RING_OFF);
        LAS int* sel_e = (LAS int*)(lds + RING_OFF + 32768);
        LAS float* sel_w = (LAS float*)(lds + RING_OFF + 32768 + 4096);
        LAS int* ebase = (LAS int*)(lds + RING_OFF + 32768 + 8192);
        const float* rw = args.in[26];
        for (int i = tid; i < 2048; i += NWAVES * 64) ((LAS f32x4*)rt)[i] = ((const f32x4*)rw)[i];
        __syncthreads();
        const int tpb = (M + G - 1) / G;
        const int m_lo = vcu * tpb, m_hi = (m_lo + tpb < M) ? m_lo + tpb : M;
        const float* gn = args.in[25];
        for (int m = m_lo + wave; m < m_hi; m += NWAVES) {
            const f32x4* xr = (const f32x4*)(out + (size_t)m * D) + lane; const f32x4* gr = (const f32x4*)gn + lane;
            f32x4 v[4]; float s = 0.f;
#pragma unroll
            for (int j = 0; j < 4; ++j) { v[j] = xr[64 * j]; s += (v[j].x * v[j].x + v[j].y * v[j].y) + (v[j].z * v[j].z + v[j].w * v[j].w); }
            const float rstd = 1.0f / sqrtf(wave_sum(s) * (1.f / D) + EPS);
            float lg[8];
#pragma unroll
            for (int e = 0; e < 8; ++e) lg[e] = 0.f;
            unsigned long long* o8 = (unsigned long long*)(XN + (size_t)m * D) + lane;
#pragma unroll
            for (int j = 0; j < 4; ++j) { const f32x4 g4 = gr[64 * j]; const float y[4] = {v[j].x * rstd * g4.x, v[j].y * rstd * g4.y, v[j].z * rstd * g4.z, v[j].w * rstd * g4.w};
                o8[64 * j] = (unsigned long long)pk2(y[0], y[1]) | ((unsigned long long)pk2(y[2], y[3]) << 32);
#pragma unroll
                for (int q = 0; q < 4; ++q) { const int k = 256 * j + 4 * lane + q; const f32x4 r0 = *(const LAS f32x4*)(rt + k * 8), r1 = *(const LAS f32x4*)(rt + k * 8 + 4);
                    lg[0] += y[q] * r0.x; lg[1] += y[q] * r0.y; lg[2] += y[q] * r0.z; lg[3] += y[q] * r0.w; lg[4] += y[q] * r1.x; lg[5] += y[q] * r1.y; lg[6] += y[q] * r1.z; lg[7] += y[q] * r1.w; } }
#pragma unroll
            for (int e = 0; e < 8; ++e) lg[e] = wave_sum(lg[e]);
            int e0 = 0; float v0 = lg[0];
#pragma unroll
            for (int e = 1; e < 8; ++e) if (lg[e] > v0) { v0 = lg[e]; e0 = e; }
            int e1 = -1; float v1 = -INFINITY;
#pragma unroll
            for (int e = 0; e < 8; ++e) if (e != e0 && lg[e] > v1) { v1 = lg[e]; e1 = e; }
            const float g1 = 1.0f / (1.0f + expf(v0 - v1)), g0 = 1.0f - g1;
            if (lane == 0) { const int tl = m - m_lo; sel_e[2 * tl] = e0; sel_e[2 * tl + 1] = e1; sel_w[2 * tl] = g0; sel_w[2 * tl + 1] = g1; }
        }
        __syncthreads();
        const int ntl = m_hi - m_lo;
        if (tid < 8 && ntl > 0) { int n = 0; for (int i = 0; i < 2 * ntl; ++i) n += (sel_e[i] == tid) ? 1 : 0;
            ebase[tid] = n ? (int)__hip_atomic_fetch_add(ctl + CW_CNT + 64 * (8 * rep + tid), (unsigned)n, RLX_AGENT) : 0; }
        __syncthreads();
        if (tid < 8 && ntl > 0) { int pos = ebase[tid]; for (int i = 0; i < 2 * ntl; ++i) if (sel_e[i] == tid) { LTOK[(size_t)(8 * rep + tid) * M + pos] = m_lo + (i >> 1) + (i & 1) * M; LW[(size_t)(8 * rep + tid) * M + pos] = sel_w[i]; ++pos; } }
        if (BOTH(16) || rep + 1 < NREP(16)) GRID_BAR();
    }
    if (IN(17)) for (int rep = 0; rep < NREP(17); ++rep) {
        LAS int* tinfo = (LAS int*)(lds + RING_OFF);
        if (tid == 0) { int acc = 0; for (int e = 0; e < 8; ++e) { const int cnt = (int)__hip_atomic_load(ctl + CW_CNT + 64 * e, RLX_AGENT); const int nt = (cnt + 255) >> 8; tinfo[e] = cnt; tinfo[8 + e] = acc;
                for (int i = 0; i < nt; ++i) tinfo[32 + acc + i] = e; acc += nt; } tinfo[16] = acc; }
        __syncthreads();
        const int nrt = tinfo[16];
        if (bx == 0) { int t2 = tid; asm volatile("" : "+v"(t2)); if (t2 < nrt) TILEE[t2] = tinfo[32 + t2]; if (tid == 0) TILEE[200] = nrt; }
        for (int s = gw; s < nrt * 256; s += NGW) {
            const int e = tinfo[32 + (s >> 8)], idxe = s - tinfo[8 + e] * 256;
            v4u a = {0u, 0u, 0u, 0u}, b2 = {0u, 0u, 0u, 0u}; int tok = -1; float w = 0.f;
            if (idxe < tinfo[e]) { tok = LTOK[(size_t)e * M + idxe]; w = LW[(size_t)e * M + idxe]; const v4u* src = (const v4u*)(XN + (size_t)(tok & (M - 1)) * D); a = src[lane]; b2 = src[64 + lane]; }
            v4u* dst = (v4u*)(XS + (size_t)s * D); dst[lane] = a; dst[64 + lane] = b2;
            if (lane == 0) { STOK[s] = tok; SWT[s] = w; }
        }
        if (BOTH(17) || rep + 1 < NREP(17)) GRID_BAR();
    }
#define MOE_PASS(PH, P) \
    if (IN(PH)) for (int rep = 0; rep < NREP(PH); ++rep) { const int nrt = __builtin_amdgcn_readfirstlane(TILEE[200]); \
        pg8::Gemm g{XS, Mgu_t, MAXSLOT, NE * 2 * FF, D}; pg8::MoeOrder S{TILEE, nrt, 14, 28, 14 * (P), G, vcu}; \
        pg8::EpiSwiGLU E{MACT, FFH, 28, 14 * (P)}; \
        pg8::gemm_phase<pg8::EpiSwiGLU, pg8::MoeOrder, true, true>(lds + RING_OFF, g, S, E); \
        if (BOTH(PH) || rep + 1 < NREP(PH)) GRID_BAR(); } \
    if (IN((PH) + 1)) for (int rep = 0; rep < NREP((PH) + 1); ++rep) { const int nrt = __builtin_amdgcn_readfirstlane(TILEE[200]); \
        pg8::Gemm g{MACT, Mdn_t + (size_t)(P) * (NE * 1024) * FFH, MAXSLOT, NE * 1024, FFH}; pg8::MoeOrder S{TILEE, nrt, 4, 4, 0, G, vcu}; \
        pg8::EpiMoeDown E{out, XN, STOK, SWT, rep ? 0.0f : 1.0f, ((P) == 0 && rep == 0) ? 1 : 0, M}; \
        pg8::gemm_phase<pg8::EpiMoeDown, pg8::MoeOrder, true, true>(lds + RING_OFF, g, S, E); \
        if (BOTH((PH) + 1) || rep + 1 < NREP((PH) + 1)) GRID_BAR(); }
    MOE_PASS(18, 0)
    MOE_PASS(20, 1)
#undef MOE_PASS
    if (IN(22)) {
        for (int m = gw; m < M; m += NGW) { f32x4* o = (f32x4*)(out + (size_t)m * D) + lane; const v2u* y = (const v2u*)(XN + (size_t)m * D) + lane;
#pragma unroll
            for (int j = 0; j < 4; ++j) { const v2u yy = y[64 * j]; f32x4 v = o[64 * j]; v.x += bflo(yy.x); v.y += bfhi(yy.x); v.z += bflo(yy.y); v.w += bfhi(yy.y); o[64 * j] = v; } }
    }
#undef IN
#undef BOTH
#undef GRID_BAR
}

extern "C" void kernel_launch(void* const* d_in, const int* in_sizes, int n_in, void* d_out, int out_size, void* d_ws, size_t ws_size, hipStream_t stream) {
    static int grid = 0;
    if (grid == 0) {
        if (n_in != 30 || in_sizes[0] != M * D || out_size != M * D || ws_size < WS_END) { fprintf(stderr, "kernel_launch: unexpected shapes (n_in %d, in0 %d, out %d, ws %zu < %zu); nothing launched\n", n_in, n_in > 0 ? in_sizes[0] : -1, out_size, ws_size, (size_t)WS_END); grid = -1; return; }
        int dev = 0, cus = 0, per_cu = 0;
        if (hipGetDevice(&dev) != hipSuccess || hipDeviceGetAttribute(&cus, hipDeviceAttributeMultiprocessorCount, dev) != hipSuccess) { grid = -1; return; }
        if (hipFuncSetAttribute((const void*)fwd, hipFuncAttributeMaxDynamicSharedMemorySize, LDS_BYTES) != hipSuccess) { fprintf(stderr, "kernel_launch: hipFuncSetAttribute failed\n"); grid = -1; return; }
        if (hipOccupancyMaxActiveBlocksPerMultiprocessor(&per_cu, (const void*)fwd, NWAVES * 64, LDS_BYTES) != hipSuccess || per_cu < 1) { fprintf(stderr, "kernel_launch: occupancy query reports %d blocks per CU\n", per_cu); (void)hipGetLastError(); grid = -1; return; }
        grid = cus;
    }
    if (grid < 0) return;
    if (hipMemsetAsync((char*)d_ws + WS_CTL, 0, CTL_ZERO_BYTES, stream) != hipSuccess) return;
    Args a{};
    for (int i = 0; i < 30; ++i) a.in[i] = (const float*)d_in[i];
    a.out = (float*)d_out; a.ws = (unsigned char*)d_ws;
#if MK_PER_PHASE
    for (int p = 0; p < NPH; ++p) { a.ph_lo = p; a.ph_hi = p + 1; hipLaunchKernelGGL(fwd, dim3(grid), dim3(NWAVES * 64), LDS_BYTES, stream, a); }
#else
    a.ph_lo = 0; a.ph_hi = NPH; hipLaunchKernelGGL(fwd, dim3(grid), dim3(NWAVES * 64), LDS_BYTES, stream, a);
#endif
}
```

```cpp
#include <hip/hip_runtime.h>
#include <cstdio>
#include <cstdint>
#include <cmath>
namespace pg8 {
#define PG8_LAS __attribute__((address_space(3)))
typedef unsigned short bf16_t;
typedef short bf16x8 __attribute__((ext_vector_type(8)));
typedef float f32x4 __attribute__((ext_vector_type(4)));
typedef unsigned u32x4 __attribute__((ext_vector_type(4)));
constexpr int BM = 256, BK = 64, HALF = 128, HTB = HALF * BK * 2  , STAGE_BYTES = 8 * HTB, NXCD = 8, WGM = 8;

__host__ __device__ __forceinline__ int lds_byte(int r, int c) { const int st = (r >> 4) * 2 + (c >> 5), rr = r & 15, cc = c & 31, ob = rr * 64 + cc * 2; return st * 1024 + (ob ^ (((ob >> 9) & 1) << 5)); }
__host__ __device__ __forceinline__ void stage_rc(int b, int& R, int& C) { const int st = b / 1024, sb = b % 1024, swz = sb ^ (((sb >> 9) & 1) << 5); R = (st >> 1) * 16 + swz / 64; C = (st & 1) * 32 + (swz % 64) / 2; }
__host__ __device__ __forceinline__ int perm32(int rho) { const int n = rho >> 4, i = rho & 15; return 8 * (i >> 2) + 4 * n + (i & 3); }

struct Unit { int pm, pn; };
struct Gemm { const bf16_t* A; const bf16_t* Bt; int M, N, K; };

struct StaticOrder {
    int nM, nN, nwg, G, c;
    __host__ __device__ void init(int M, int N, int G_, int c_) { nM = M / BM; nN = N / BM; nwg = nM * nN; G = G_; c = c_; }
    __host__ __device__ bool next(int i, Unit& u) const {
        const long L = (long)i * G + c; if (L >= nwg) return false;
        int wgid = (int)L; { const int q = nwg / NXCD, r = nwg % NXCD, xcd = wgid % NXCD, off = wgid / NXCD; wgid = (xcd < r ? xcd * (q + 1) : r * (q + 1) + (xcd - r) * q) + off; }
        const int nig = WGM * nN, gid = wgid / nig, fm = gid * WGM, gsz = (nM - fm) < WGM ? (nM - fm) : WGM;
        u.pm = fm + ((wgid % nig) % gsz); u.pn = (wgid % nig) / gsz; return true;
    }
    __device__ __forceinline__ void a_ready(const Unit&) const {}
    __device__ __forceinline__ void done(const Unit&) const {}
};

__device__ __forceinline__ unsigned cvt_pk_bf16(float lo, float hi) { unsigned r; asm volatile("v_cvt_pk_bf16_f32 %0, %1, %2" : "=v"(r) : "v"(lo), "v"(hi)); return r; }
typedef float f32x2 __attribute__((ext_vector_type(2)));
typedef float f32x2 __attribute__((ext_vector_type(2)));
__device__ __forceinline__ float fast_sigmoid(float x) { return __builtin_amdgcn_rcpf(1.0f + __expf(-x)); }
struct EpiBf16Plain {
    static constexpr bool PERM = true, AFTER_DRAIN = false;
    bf16_t* O; int ldc;
    __device__ __forceinline__ void operator()(const f32x4 (&acc)[2][2][4][2], const Unit& u, int wr, int wc, int fr, int fq) const {
        const int row0 = u.pm * BM + wr * 64 + fr, col0 = u.pn * BM + wc * 32 + 8 * fq;
#pragma unroll
        for (int ai = 0; ai < 2; ++ai)
#pragma unroll
            for (int m = 0; m < 4; ++m) { bf16_t* rowp = O + (size_t)(row0 + ai * HALF + m * 16) * ldc + col0;
#pragma unroll
                for (int bj = 0; bj < 2; ++bj) { const f32x4 v0 = acc[ai][bj][m][0], v1 = acc[ai][bj][m][1];
                    u32x4 w; w.x = cvt_pk_bf16(v0[0], v0[1]); w.y = cvt_pk_bf16(v0[2], v0[3]); w.z = cvt_pk_bf16(v1[0], v1[1]); w.w = cvt_pk_bf16(v1[2], v1[3]);
                    *(u32x4*)(rowp + bj * HALF) = w; } }
    }
};
struct EpiResF32 {
    static constexpr bool PERM = false, AFTER_DRAIN = false;
    const float* base; float* out; int ldc; float scale;
    __device__ __forceinline__ void operator()(const f32x4 (&acc)[2][2][4][2], const Unit& u, int wr, int wc, int fr, int fq) const {
        const int col0 = u.pn * BM + wc * 32 + 4 * fq;
#pragma unroll
        for (int ai = 0; ai < 2; ++ai)
#pragma unroll
            for (int m = 0; m < 4; ++m) { const int r = ai * HALF + wr * 64 + m * 16 + fr; const size_t off = (size_t)(u.pm * BM + r) * ldc + col0;
#pragma unroll
                for (int bj = 0; bj < 2; ++bj)
#pragma unroll
                    for (int n = 0; n < 2; ++n) { const size_t o = off + bj * HALF + n * 16; f32x4 v = acc[ai][bj][m][n] * scale; if (base) v = v + *(const f32x4*)(base + o); *(f32x4*)(out + o) = v; } }
    }
};
struct EpiSwiGLU {
    static constexpr bool PERM = true, AFTER_DRAIN = false;
    bf16_t* O; int ldc, ngrp, sub;
    __device__ __forceinline__ void operator()(const f32x4 (&acc)[2][2][4][2], const Unit& u, int wr, int wc, int fr, int fq) const {
        const int ct = (u.pn % ngrp) - sub; const int row0 = u.pm * BM + wr * 64 + fr, col0 = ct * HALF + wc * 32 + 8 * fq;
#pragma unroll
        for (int ai = 0; ai < 2; ++ai)
#pragma unroll
            for (int m = 0; m < 4; ++m) { bf16_t* rowp = O + (size_t)(row0 + ai * HALF + m * 16) * ldc + col0;
                f32x4 a[2];
#pragma unroll
                for (int n = 0; n < 2; ++n) { const f32x4 g = acc[ai][0][m][n], up = acc[ai][1][m][n];
#pragma unroll
                    for (int j = 0; j < 4; ++j) a[n][j] = g[j] * fast_sigmoid(g[j]) * up[j]; }
                u32x4 w; w.x = cvt_pk_bf16(a[0][0], a[0][1]); w.y = cvt_pk_bf16(a[0][2], a[0][3]); w.z = cvt_pk_bf16(a[1][0], a[1][1]); w.w = cvt_pk_bf16(a[1][2], a[1][3]);
                *(u32x4*)rowp = w; }
    }
};
struct EpiGLU {
    static constexpr bool PERM = false, AFTER_DRAIN = false;
    float* out; int ldc; float scale;
    __device__ __forceinline__ void operator()(const f32x4 (&acc)[2][2][4][2], const Unit& u, int wr, int wc, int fr, int fq) const {
        const int col0 = u.pn * HALF + wc * 32 + 4 * fq;
#pragma unroll
        for (int ai = 0; ai < 2; ++ai)
#pragma unroll
            for (int m = 0; m < 4; ++m) { const int r = ai * HALF + wr * 64 + m * 16 + fr; const size_t off = (size_t)(u.pm * BM + r) * ldc + col0;
#pragma unroll
                for (int n = 0; n < 2; ++n) { const size_t o = off + n * 16; const f32x4 a = acc[ai][0][m][n], g = acc[ai][1][m][n]; f32x4 v = *(const f32x4*)(out + o);
#pragma unroll
                    for (int j = 0; j < 4; ++j) v[j] += scale * a[j] * fast_sigmoid(g[j]);
                    *(f32x4*)(out + o) = v; } }
    }
};
struct EpiMoeDown {
    static constexpr bool PERM = false, AFTER_DRAIN = false;
    float* out; bf16_t* Y1; const int* slot_tok; const float* slot_w; float scale; int first; int ntok;
    __device__ __forceinline__ void operator()(const f32x4 (&acc)[2][2][4][2], const Unit& u, int wr, int wc, int fr, int fq) const {
        typedef unsigned u32x2 __attribute__((ext_vector_type(2)));
        const int colb = (u.pn & 3) * BM + wc * 32 + 4 * fq;
#pragma unroll
        for (int ai = 0; ai < 2; ++ai)
#pragma unroll
            for (int m = 0; m < 4; ++m) { const int s = u.pm * BM + ai * HALF + wr * 64 + m * 16 + fr; const int tv = slot_tok[s]; const float w = slot_w[s] * scale;
                if (tv >= 0 && tv < ntok) { float* orow = out + (size_t)tv * 1024 + colb;
#pragma unroll
                    for (int bj = 0; bj < 2; ++bj)
#pragma unroll
                        for (int n = 0; n < 2; ++n) { float* p = orow + bj * HALF + n * 16; *(f32x4*)p = *(const f32x4*)p + acc[ai][bj][m][n] * w; } }
                else if (tv >= ntok) { bf16_t* yrow = Y1 + (size_t)(tv - ntok) * 1024 + colb;
#pragma unroll
                    for (int bj = 0; bj < 2; ++bj)
#pragma unroll
                        for (int n = 0; n < 2; ++n) { bf16_t* p = yrow + bj * HALF + n * 16; f32x4 v = acc[ai][bj][m][n] * w;
                            if (!first) { const u32x2 o = *(const u32x2*)p; v[0] += __uint_as_float(o.x << 16); v[1] += __uint_as_float(o.x & 0xffff0000u); v[2] += __uint_as_float(o.y << 16); v[3] += __uint_as_float(o.y & 0xffff0000u); }
                            u32x2 r; r.x = cvt_pk_bf16(v[0], v[1]); r.y = cvt_pk_bf16(v[2], v[3]); *(u32x2*)p = r; } } }
    }
};
struct MoeOrder {
    const int* tile_e; int nrt, ncol, mul, coloff, G, c;
    __device__ __forceinline__ bool next(int i, Unit& u) const {
        const int L = i * G + c; if (L >= nrt * ncol) return false;
        const int rt = L / ncol, jj = L - rt * ncol; const int e = __builtin_amdgcn_readfirstlane(tile_e[rt]);
        u.pm = rt; u.pn = e * mul + coloff + jj; return true;
    }
    __device__ __forceinline__ void a_ready(const Unit&) const {}
    __device__ __forceinline__ void done(const Unit&) const {}
};

template <class Epi, class Sched, bool ALIGN_EPI = false, bool SP2 = false>
__device__ __forceinline__ void gemm_phase(PG8_LAS unsigned char* lds, const Gemm g, const Sched& S, const Epi& E) {
    const int tid = threadIdx.x, wid = __builtin_amdgcn_readfirstlane(tid >> 6), lane = tid & 63, wr = wid >> 2, wc = wid & 3, fr = lane & 15, fq = lane >> 4;
    const int K = g.K, nt = K / BK;
    unsigned voffA[2], voffB[2];
#pragma unroll
    for (int i = 0; i < 2; ++i) { int R, C; stage_rc(tid * 16 + i * 8192, R, C); const int Rb = Epi::PERM ? ((R & ~31) + perm32(R & 31)) : R;
        voffA[i] = (unsigned)(R * K + C) * 2u; voffB[i] = (unsigned)(Rb * K + C) * 2u; }
    const size_t kstep = (size_t)(BK * 2);
    const size_t hstep = (size_t)HALF * K * 2;
    const size_t tstep = 2 * hstep;
    const unsigned ldsw = (unsigned)wid * 1024u;
    const int aoff = lds_byte(wr * 64 + fr, fq * 8), boff = lds_byte(wc * 32 + fr, fq * 8);
#define PG8_SA(b, h) (((b) * 2 + (h)) * HTB)
#define PG8_SB(b, h) ((4 + (b) * 2 + (h)) * HTB)
#define PG8_STAGE(bufoff, gbase, voff) do { _Pragma("unroll") for (int _i = 0; _i < 2; ++_i) \
        __builtin_amdgcn_global_load_lds((const unsigned*)((const char*)(gbase) + (voff)[_i]), (PG8_LAS unsigned*)(lds + (bufoff) + ldsw + _i * 8192), 16, 0, 0); } while (0)
#define PG8_LDA(dst, b, h) do { _Pragma("unroll") for (int m = 0; m < 4; ++m) _Pragma("unroll") for (int k = 0; k < 2; ++k) dst[m][k] = *(const PG8_LAS bf16x8*)(lds + PG8_SA(b, h) + aoff + m * 2048 + k * 1024); } while (0)
#define PG8_LDB(dst, b, h) do { _Pragma("unroll") for (int n = 0; n < 2; ++n) _Pragma("unroll") for (int k = 0; k < 2; ++k) dst[n][k] = *(const PG8_LAS bf16x8*)(lds + PG8_SB(b, h) + boff + n * 2048 + k * 1024); } while (0)
#define PG8_MMA(ai, bj, At, Bt) do { __builtin_amdgcn_s_setprio(1); _Pragma("unroll") for (int m = 0; m < 4; ++m) _Pragma("unroll") for (int n = 0; n < 2; ++n) _Pragma("unroll") for (int k = 0; k < 2; ++k) \
        acc[ai][bj][m][n] = __builtin_amdgcn_mfma_f32_16x16x32_bf16(Bt[n][k], At[m][k], acc[ai][bj][m][n], 0, 0, 0); __builtin_amdgcn_s_setprio(0); } while (0)
#define PG8_WAIT_V(n) asm volatile("s_waitcnt vmcnt(" #n ")" ::: "memory")
#define PG8_WAIT_L(n) asm volatile("s_waitcnt lgkmcnt(" #n ")" ::: "memory")
#define PG8_BAR __builtin_amdgcn_s_barrier()
#define PG8_SCHED __builtin_amdgcn_sched_barrier(0)
    Unit cur, nxt; int ui = 0;
    if (!S.next(0, cur)) return;
    f32x4 acc[2][2][4][2];
#pragma unroll
    for (int a = 0; a < 2; ++a)
#pragma unroll
        for (int b = 0; b < 2; ++b)
#pragma unroll
            for (int m = 0; m < 4; ++m)
#pragma unroll
                for (int n = 0; n < 2; ++n) acc[a][b][m][n] = (f32x4){0.f, 0.f, 0.f, 0.f};
    bf16x8 At[4][2], B0[2][2], B1[2][2];
    const char* cA = (const char*)g.A + (size_t)cur.pm * tstep; const char* cB = (const char*)g.Bt + (size_t)cur.pn * tstep;
    S.a_ready(cur);
    if constexpr (SP2) {
        PG8_STAGE(PG8_SB(0, 0), cB, voffB); PG8_STAGE(PG8_SB(0, 1), cB + hstep, voffB); PG8_STAGE(PG8_SA(0, 0), cA, voffA); PG8_STAGE(PG8_SA(0, 1), cA + hstep, voffA);
        if (wr == 1) PG8_BAR;
        PG8_WAIT_V(2); PG8_BAR;
        PG8_STAGE(PG8_SB(1, 0), cB + kstep, voffB); PG8_STAGE(PG8_SA(1, 0), cA + kstep, voffA); PG8_STAGE(PG8_SB(1, 1), cB + hstep + kstep, voffB);
        PG8_WAIT_V(6); PG8_BAR;
    } else {
        PG8_STAGE(PG8_SB(0, 0), cB, voffB); PG8_STAGE(PG8_SA(0, 0), cA, voffA); PG8_STAGE(PG8_SB(0, 1), cB + hstep, voffB); PG8_STAGE(PG8_SA(0, 1), cA + hstep, voffA);
        if (wr == 1) PG8_BAR;
        PG8_WAIT_V(4); PG8_BAR;
        PG8_STAGE(PG8_SB(1, 0), cB + kstep, voffB); PG8_STAGE(PG8_SA(1, 0), cA + kstep, voffA); PG8_STAGE(PG8_SB(1, 1), cB + hstep + kstep, voffB);
        PG8_WAIT_V(6); PG8_BAR;
    }
    for (;;) {
        const bool has_next = S.next(ui + 1, nxt);
        const char* nA = has_next ? (const char*)g.A + (size_t)nxt.pm * tstep : cA; const char* nB = has_next ? (const char*)g.Bt + (size_t)nxt.pn * tstep : cB;
        for (int t = 0; t < nt; t += 2) {
            const bool last = (t == nt - 2);
            const char* a1 = cA + (size_t)(t + 1) * kstep;
            const char* a2 = last ? nA : cA + (size_t)(t + 2) * kstep; const char* b2 = last ? nB : cB + (size_t)(t + 2) * kstep;
            const char* a3 = a2 + kstep; const char* b3 = b2 + kstep;
            if (last && has_next) S.a_ready(nxt);
            if constexpr (SP2) {
            PG8_LDB(B0, 0, 0); PG8_LDB(B1, 0, 1); PG8_SCHED; PG8_LDA(At, 0, 0); PG8_STAGE(PG8_SA(1, 1), a1 + hstep, voffA);
            PG8_WAIT_V(8); PG8_WAIT_L(0); PG8_BAR; PG8_MMA(0, 0, At, B0); PG8_MMA(0, 1, At, B1); PG8_BAR; PG8_SCHED;
            PG8_LDA(At, 0, 1); PG8_STAGE(PG8_SB(0, 0), b2, voffB); PG8_STAGE(PG8_SB(0, 1), b2 + hstep, voffB); PG8_STAGE(PG8_SA(0, 0), a2, voffA);
            PG8_WAIT_V(8); PG8_WAIT_L(0); PG8_BAR; PG8_MMA(1, 0, At, B0); PG8_MMA(1, 1, At, B1); PG8_BAR; PG8_SCHED;
            PG8_LDB(B0, 1, 0); PG8_LDB(B1, 1, 1); PG8_SCHED; PG8_LDA(At, 1, 0); PG8_STAGE(PG8_SA(0, 1), a2 + hstep, voffA);
            PG8_WAIT_V(8); PG8_WAIT_L(0); PG8_BAR; PG8_MMA(0, 0, At, B0); PG8_MMA(0, 1, At, B1); PG8_BAR; PG8_SCHED;
            PG8_LDA(At, 1, 1); PG8_STAGE(PG8_SB(1, 0), b3, voffB); PG8_STAGE(PG8_SB(1, 1), b3 + hstep, voffB); PG8_STAGE(PG8_SA(1, 0), a3, voffA);
            PG8_WAIT_V(8); PG8_WAIT_L(0); PG8_BAR; PG8_MMA(1, 0, At, B0); PG8_MMA(1, 1, At, B1); PG8_BAR; PG8_SCHED;
            } else {
            PG8_LDB(B0, 0, 0); PG8_SCHED; PG8_LDA(At, 0, 0); PG8_STAGE(PG8_SA(1, 1), a1 + hstep, voffA);
            PG8_WAIT_L(8); PG8_BAR; PG8_WAIT_L(0); PG8_MMA(0, 0, At, B0); PG8_BAR; PG8_SCHED;
            PG8_LDB(B1, 0, 1); PG8_STAGE(PG8_SB(0, 0), b2, voffB);
            PG8_BAR; PG8_WAIT_L(0); PG8_MMA(0, 1, At, B1); PG8_BAR;
            PG8_LDA(At, 0, 1); PG8_STAGE(PG8_SA(0, 0), a2, voffA);
            PG8_BAR; PG8_WAIT_L(0); PG8_MMA(1, 0, At, B0); PG8_BAR; PG8_SCHED;
            PG8_STAGE(PG8_SB(0, 1), b2 + hstep, voffB);
            PG8_WAIT_V(6); PG8_BAR; PG8_MMA(1, 1, At, B1); PG8_BAR;
            PG8_LDB(B0, 1, 0); PG8_SCHED; PG8_LDA(At, 1, 0); PG8_STAGE(PG8_SA(0, 1), a2 + hstep, voffA);
            PG8_WAIT_L(8); PG8_BAR; PG8_WAIT_L(0); PG8_MMA(0, 0, At, B0); PG8_BAR; PG8_SCHED;
            PG8_LDB(B1, 1, 1); PG8_STAGE(PG8_SB(1, 0), b3, voffB);
            PG8_BAR; PG8_WAIT_L(0); PG8_MMA(0, 1, At, B1); PG8_BAR;
            PG8_LDA(At, 1, 1); PG8_STAGE(PG8_SA(1, 0), a3, voffA);
            PG8_BAR; PG8_WAIT_L(0); PG8_MMA(1, 0, At, B0); PG8_BAR; PG8_SCHED;
            PG8_STAGE(PG8_SB(1, 1), b3 + hstep, voffB);
            PG8_WAIT_V(6); PG8_BAR; PG8_MMA(1, 1, At, B1); PG8_BAR;
            }
        }
        if constexpr (ALIGN_EPI) { if (wr == 0) PG8_BAR; }
        if constexpr (!Epi::AFTER_DRAIN) { E(acc, cur, wr, wc, fr, fq); S.done(cur); }
        if (!has_next) break;
#pragma unroll
        for (int a = 0; a < 2; ++a)
#pragma unroll
            for (int b = 0; b < 2; ++b)
#pragma unroll
                for (int m = 0; m < 4; ++m)
#pragma unroll
                    for (int n = 0; n < 2; ++n) acc[a][b][m][n] = (f32x4){0.f, 0.f, 0.f, 0.f};
        cur = nxt; cA = nA; cB = nB; ++ui;
        if constexpr (ALIGN_EPI) { if (wr == 1) PG8_BAR; }
    }
    PG8_WAIT_V(0);
    if constexpr (!ALIGN_EPI) { if (wr == 0) PG8_BAR; }
    PG8_BAR;
    if constexpr (Epi::AFTER_DRAIN) { E.fused(acc, cur, wr, wc, fr, fq, lds, wid, lane); S.done(cur); }
#undef PG8_SA
#undef PG8_SB
#undef PG8_STAGE
#undef PG8_LDA
#undef PG8_LDB
#undef PG8_MMA
#undef PG8_WAIT_V
#undef PG8_WAIT_L
#undef PG8_BAR
#undef PG8_SCHED
}
}
#define LAS __attribute__((address_space(3)))
#define XB_TMO      128
#define XB_XCNT(j)  (256  + 64 * (j))
#define XB_XSUB(j)  (1280 + 64 * (j))
#define XB_XGEN(j)  (2304 + 64 * (j))
#define XB_TOP      3328
#define XB_TOPGEN   3392
#define XCD_BAR_WORDS 3456
#define XB_SPIN_CAP (1u << 18)

__device__ __forceinline__ unsigned xb_ld(unsigned* p)              { return __hip_atomic_load(p, __ATOMIC_RELAXED, __HIP_MEMORY_SCOPE_AGENT); }
__device__ __forceinline__ unsigned xb_add(unsigned* p, unsigned v) { return __hip_atomic_fetch_add(p, v, __ATOMIC_RELAXED, __HIP_MEMORY_SCOPE_AGENT); }
__device__ __forceinline__ unsigned xb_xcc_id() { return (unsigned)__builtin_amdgcn_s_getreg((3 << 11) | 20) & 0xFu; }
#define XB_SPIN(cond, bar) do { unsigned _sp = 0; while (cond) { __builtin_amdgcn_s_sleep(1); \
    if ((++_sp & 255u) == 0u) { if (xb_ld(&(bar)[XB_TMO])) break; if (_sp > XB_SPIN_CAP) { atomicAdd(&(bar)[XB_TMO], 1u); break; } } } } while (0)

struct XcdBarrier {
    unsigned* bar; unsigned x;
    volatile LAS unsigned* st;
};

__device__ __forceinline__ XcdBarrier xcd_barrier_post(unsigned* bar, volatile LAS unsigned* st) {
    XcdBarrier b; b.bar = bar; b.x = xb_xcc_id(); b.st = st;
    if (threadIdx.x == 0) (void)xb_add(&bar[XB_XCNT(b.x)], 1u);
    return b;
}
__device__ __forceinline__ void xcd_barrier_complete(unsigned* bar, unsigned x, unsigned& nloc, unsigned& nx) {
    const unsigned G = gridDim.x * gridDim.y * gridDim.z;
    unsigned sum, cnt, mine, sp = 0u;
    for (;;) {
        sum = 0u; cnt = 0u; mine = 0u;
#pragma unroll
        for (unsigned j = 0; j < 16; ++j) { const unsigned c = xb_ld(&bar[XB_XCNT(j)]); sum += c; cnt += (c > 0u) ? 1u : 0u; mine = (j == x) ? c : mine; }
        if (sum == G) break;
        __builtin_amdgcn_s_sleep(1);
        if ((++sp & 255u) == 0u) { if (xb_ld(&bar[XB_TMO])) break; if (sp > XB_SPIN_CAP) { atomicAdd(&bar[XB_TMO], 1u); break; } }
    }
    nloc = mine > 0u ? mine : 1u; nx = cnt > 0u ? cnt : 1u;
}

__device__ __forceinline__ void xcd_barrier(const XcdBarrier& b) {
    asm volatile("s_waitcnt vmcnt(0)" ::: "memory");
    __syncthreads();
    if (threadIdx.x == 0) {
        unsigned* bar = b.bar;
        __builtin_amdgcn_s_waitcnt(0);
        unsigned nloc = b.st[0], nx = b.st[1];
        if (nloc == 0u) { xcd_barrier_complete(bar, b.x, nloc, nx); b.st[0] = nloc; b.st[1] = nx; }
        const unsigned old = xb_add(&bar[XB_XSUB(b.x)], 1u);
        const unsigned gen = old / nloc;
        if (old + 1u == (gen + 1u) * nloc) {
            __builtin_amdgcn_fence(__ATOMIC_RELEASE, "agent");
            asm volatile("s_waitcnt vmcnt(0)" ::: "memory");
            const unsigned og = xb_add(&bar[XB_TOP], 1u);
            const unsigned tg = og / nx;
            if (og + 1u == (tg + 1u) * nx) xb_add(&bar[XB_TOPGEN], 1u);
            else XB_SPIN(xb_ld(&bar[XB_TOPGEN]) == tg, bar);
            __builtin_amdgcn_fence(__ATOMIC_ACQUIRE, "agent");
            xb_add(&bar[XB_XGEN(b.x)], 1u);
            asm volatile("s_waitcnt vmcnt(0)" ::: "memory");
        } else {
            XB_SPIN(xb_ld(&bar[XB_XGEN(b.x)]) == gen, bar);
            __builtin_amdgcn_fence(__ATOMIC_ACQUIRE, "agent");
            asm volatile("s_waitcnt vmcnt(0)" ::: "memory");
        }
    }
    __syncthreads();
}
#define GAS __attribute__((address_space(1)))
typedef unsigned short bf16;
typedef unsigned v4u __attribute__((ext_vector_type(4)));
typedef unsigned v2u __attribute__((ext_vector_type(2)));
typedef float f32x4 __attribute__((ext_vector_type(4)));
typedef float f32x16 __attribute__((ext_vector_type(16)));
typedef float f32x2 __attribute__((ext_vector_type(2)));
typedef short bf16x8 __attribute__((ext_vector_type(8)));
typedef GAS unsigned gu32;
#define RLX_AGENT __ATOMIC_RELAXED, __HIP_MEMORY_SCOPE_AGENT
#define LDS_WAIT() asm volatile("s_waitcnt lgkmcnt(0)" ::: "memory")
#define VM_WAIT() asm volatile("s_waitcnt vmcnt(0)" ::: "memory")
__device__ __forceinline__ unsigned f2bf(float f) { unsigned u = __builtin_bit_cast(unsigned, f); return (u + 0x7fffu + ((u >> 16) & 1u)) >> 16; }
__device__ __forceinline__ unsigned pk2(float lo, float hi) { return f2bf(lo) | (f2bf(hi) << 16); }
__device__ __forceinline__ float bflo(unsigned u) { return __uint_as_float(u << 16); }
__device__ __forceinline__ float bfhi(unsigned u) { return __uint_as_float(u & 0xffff0000u); }

constexpr int NWAVES = 8;
constexpr int SEQ = 8192, NB = 2, M = NB * SEQ, D = 1024;
constexpr int INC = 1952, INP = 2048;
constexpr int FF = 3584, NE = 8;
constexpr int SW = 512;
constexpr int CH = 128, NCH = SEQ / CH;
constexpr int FFH = FF / 2;
constexpr int MAXSLOT = 2 * M + NE * 256;
constexpr float EPS = 1e-6f;
constexpr size_t MiB = 1u << 20;
constexpr size_t WS_CTL = 0, CTL_ZERO_BYTES = 1 * MiB;
constexpr size_t WS_WIN = 1 * MiB;
constexpr size_t WS_WQUP = 5 * MiB;
constexpr size_t WS_WKVUP = 5 * MiB + 512 * 1024;
constexpr size_t WS_WOUT = 6 * MiB;
constexpr size_t WS_WDGU = 8 * MiB;
constexpr size_t WS_WDDN = 22 * MiB;
constexpr size_t WS_WSIN = 29 * MiB;
constexpr size_t WS_WGLU = 30 * MiB;
constexpr size_t WS_MGU = 32 * MiB;
constexpr size_t WS_MDN = 144 * MiB;
constexpr size_t WS_XN = 200 * MiB;
constexpr size_t WS_H = 32 * MiB;
constexpr size_t WS_QRAW = 96 * MiB;
constexpr size_t WS_KVRAW = 120 * MiB;
constexpr size_t WS_QM = 152 * MiB;
constexpr size_t WS_KM = 176 * MiB;
constexpr size_t WS_MERGED = 232 * MiB;
constexpr size_t WS_CQ = 264 * MiB;
constexpr size_t WS_CKV = 272 * MiB;
constexpr size_t WS_DACT = 32 * MiB;
constexpr size_t WS_U = 232 * MiB;
constexpr size_t WS_HEND = 264 * MiB;
constexpr size_t WS_Y = 266 * MiB;
constexpr size_t WS_XS = 232 * MiB;
constexpr size_t WS_MACT = 300 * MiB;
constexpr size_t WS_LTOK = 420 * MiB;
constexpr size_t WS_LW = 421 * MiB;
constexpr size_t WS_STOK = 422 * MiB;
constexpr size_t WS_SW = 423 * MiB;
constexpr size_t WS_TILEE = 424 * MiB;
constexpr size_t WS_ROPE = 458 * MiB;
constexpr size_t WS_STAB = 459 * MiB;
constexpr size_t WS_END = 460 * MiB;
static_assert(WS_XS + (size_t)MAXSLOT * 1024 * 2 <= WS_MACT && WS_MACT + (size_t)MAXSLOT * FFH * 2 <= WS_LTOK, "moe map");
constexpr int CW_BAR = 4096;
constexpr int CW_QUEUE = 16384;
constexpr int CW_CNT = 16384 + 64;
constexpr int RING_OFF = 0, RING_BYTES = 131072;
constexpr int LDSCTL_OFF = RING_BYTES, MISC_OFF = LDSCTL_OFF + 320;
constexpr int LDS_BYTES = 147456;

__device__ __forceinline__ float wave_sum(float v) {
#pragma unroll
    for (int o = 1; o < 64; o <<= 1) v += __shfl_xor(v, o);
    return v;
}
__device__ __forceinline__ float wave_max(float v) {
#pragma unroll
    for (int o = 1; o < 64; o <<= 1) v = fmaxf(v, __shfl_xor(v, o));
    return v;
}

__device__ __forceinline__ void transpose_item(const float* __restrict__ W, int N, int k0, int n0, bf16* dst, int dpitch, LAS float* scr, int lane) {
    f32x4 v[8];
    const int kr = lane >> 3, nq = (lane & 7) * 4;
#pragma unroll
    for (int i = 0; i < 8; ++i) v[i] = *(const f32x4*)(W + (size_t)(k0 + 8 * i + kr) * N + n0 + nq);
#pragma unroll
    for (int i = 0; i < 8; ++i) *(LAS f32x4*)(scr + (8 * i + kr) * 36 + nq) = v[i];
    LDS_WAIT(); asm volatile("" ::: "memory");
    const int c = lane & 7;
#pragma unroll
    for (int j = 0; j < 4; ++j) { const int n = (lane >> 3) + 8 * j; const LAS float* s = scr + (8 * c) * 36 + n;
        v4u o; o.x = pk2(s[0 * 36], s[1 * 36]); o.y = pk2(s[2 * 36], s[3 * 36]); o.z = pk2(s[4 * 36], s[5 * 36]); o.w = pk2(s[6 * 36], s[7 * 36]);
        *(GAS v4u*)(dst + (size_t)n * dpitch + 8 * c) = o; }
    LDS_WAIT(); asm volatile("" ::: "memory");
}
__device__ __forceinline__ void rms_row_to_bf16(const float* xrow, const float* __restrict__ gain, bf16* orow, int lane) {
    const f32x4* xr = (const f32x4*)xrow + lane; const f32x4* gr = (const f32x4*)gain + lane;
    f32x4 v[4]; float s = 0.f;
#pragma unroll
    for (int j = 0; j < 4; ++j) { v[j] = xr[64 * j]; s += (v[j].x * v[j].x + v[j].y * v[j].y) + (v[j].z * v[j].z + v[j].w * v[j].w); }
    const float rstd = 1.0f / sqrtf(wave_sum(s) * (1.f / D) + EPS);
    unsigned long long* o8 = (unsigned long long*)orow + lane;
#pragma unroll
    for (int j = 0; j < 4; ++j) { const f32x4 g = gr[64 * j];
        o8[64 * j] = (unsigned long long)pk2(v[j].x * rstd * g.x, v[j].y * rstd * g.y) | ((unsigned long long)pk2(v[j].z * rstd * g.z, v[j].w * rstd * g.w) << 32); }
}

__device__ __forceinline__ float gelu_tanh(float x) {
    const float a = 0.7978845608028654f * (x + 0.044715f * x * x * x);
    const float t = 1.0f - 2.0f * __builtin_amdgcn_rcpf(1.0f + __expf(2.0f * a));
    return 0.5f * x * (1.0f + t);
}

__device__ __forceinline__ int crow(int r, int hi) { return (r & 3) + 8 * (r >> 2) + 4 * hi; }
typedef float f32x2_t __attribute__((ext_vector_type(2))); typedef __bf16 bf16x2_t __attribute__((ext_vector_type(2)));
__device__ __forceinline__ unsigned cvtpk(float lo, float hi) { f32x2_t v = {lo, hi}; bf16x2_t b = __builtin_convertvector(v, bf16x2_t); return __builtin_bit_cast(unsigned, b); }
template <int DQK, bool SB, bool FIXREF>
__device__ __forceinline__ void attn_unit(LAS unsigned char* lds, const bf16* Qp, int qpitch, const bf16* Kp, int kpitch, const bf16* Vp, int vpitch, bf16* Op, int opitch, int qb, int tid, int wid, int lane, float negref) {
    constexpr int KROW = (DQK + 8) * 2, VROW = 144, KBUF = 64 * KROW, VBUF = 64 * VROW, VT_OFF = 2 * KBUF, FLAG_OFF = VT_OFF + 2 * VBUF, NKS = DQK / 16, KCH = DQK / 8;
    constexpr bool K2 = (64 * KCH > NWAVES * 64);
    const int r32 = lane & 31, hi = lane >> 5;
    const int qrow0 = qb * 256 + wid * 32;
    bf16x8 qr[NKS];
#pragma unroll
    for (int ks = 0; ks < NKS; ++ks) qr[ks] = *(const bf16x8*)(Qp + (size_t)(qrow0 + r32) * qpitch + ks * 16 + hi * 8);
    f32x16 o0, o1;
#pragma unroll
    for (int r = 0; r < 16; ++r) { o0[r] = 0.f; o1[r] = 0.f; }
    float m_run = -INFINITY, l_run = 0.f, A = 0.f;
    const int ntiles = 4 * qb + 4;
    LAS int* flags = (LAS int*)(lds + FLAG_OFF);
    if (SB) { if (tid < 16) flags[tid] = 0; }
    const int qglob = qrow0 + r32;
    const int k0row = tid / KCH, k0ch = tid - k0row * KCH; const int c1 = NWAVES * 64 + tid; const int k1row = c1 / KCH, k1ch = c1 - k1row * KCH; const bool has1 = K2 && (c1 < 64 * KCH);
    const int vrow = tid >> 3, vch = tid & 7;
    const bf16* kg0 = Kp + (size_t)k0row * kpitch + k0ch * 8; const bf16* kg1 = Kp + (size_t)k1row * kpitch + k1ch * 8; const bf16* vg = Vp + (size_t)vrow * vpitch + vch * 8;
    const int kl0 = k0row * KROW + k0ch * 16, kl1 = k1row * KROW + k1ch * 16, vl = (vch * 8) * VROW + vrow * 2;
    v4u kr0, kr1 = {0u, 0u, 0u, 0u}, vr;
#define ATT_LOAD(j) do { const size_t ko = (size_t)(j) * 64 * kpitch, vo = (size_t)(j) * 64 * vpitch; kr0 = *(const v4u*)(kg0 + ko); if (has1) kr1 = *(const v4u*)(kg1 + ko); vr = *(const v4u*)(vg + vo); } while (0)
#define ATT_STORE(buf) do { LAS unsigned char* kb_ = lds + (buf) * KBUF; *(LAS v4u*)(kb_ + kl0) = kr0; if (has1) *(LAS v4u*)(kb_ + kl1) = kr1; \
        LAS unsigned short* vt_ = (LAS unsigned short*)(lds + VT_OFF + (buf) * VBUF + vl); \
        vt_[0 * (VROW / 2)] = (unsigned short)(vr.x & 0xffffu); vt_[1 * (VROW / 2)] = (unsigned short)(vr.x >> 16); vt_[2 * (VROW / 2)] = (unsigned short)(vr.y & 0xffffu); vt_[3 * (VROW / 2)] = (unsigned short)(vr.y >> 16); \
        vt_[4 * (VROW / 2)] = (unsigned short)(vr.z & 0xffffu); vt_[5 * (VROW / 2)] = (unsigned short)(vr.z >> 16); vt_[6 * (VROW / 2)] = (unsigned short)(vr.w & 0xffffu); vt_[7 * (VROW / 2)] = (unsigned short)(vr.w >> 16); } while (0)
    ATT_LOAD(SB ? (ntiles - 1) : 0);
    ATT_STORE(0);
    __syncthreads();
    for (int it = 0; it < ntiles; ++it) {
        const int j = SB ? (ntiles - 1 - it) : it;
        const int kv0 = j * 64, cur = it & 1;
        if (SB && it > 0) { bool alldead = true; const LAS int* fl = flags + ((it - 1) & 1) * 8;
#pragma unroll
            for (int w = 0; w < 8; ++w) alldead = alldead && (fl[w] != 0);
            if (alldead) break; }
        const bool more = (it + 1 < ntiles);
        if (more) ATT_LOAD(SB ? (j - 1) : (j + 1));
        const LAS unsigned char* kb = lds + cur * KBUF; const LAS unsigned char* vtb = lds + VT_OFF + cur * VBUF;
        bool dead = false;
        if (kv0 <= qrow0 + 31) {
        bf16x8 kf0[NKS], kf1[NKS];
#pragma unroll
        for (int ks = 0; ks < NKS; ++ks) { kf0[ks] = *(const LAS bf16x8*)(kb + r32 * KROW + ks * 32 + hi * 16); kf1[ks] = *(const LAS bf16x8*)(kb + (32 + r32) * KROW + ks * 32 + hi * 16); }
        __builtin_amdgcn_sched_barrier(0);
        f32x16 p0, p1;
#pragma unroll
        for (int r = 0; r < 16; ++r) { p0[r] = FIXREF ? negref : 0.f; p1[r] = FIXREF ? negref : 0.f; }
#pragma unroll
        for (int ks = 0; ks < NKS; ++ks) {
            p0 = __builtin_amdgcn_mfma_f32_32x32x16_bf16(kf0[ks], qr[ks], p0, 0, 0, 0);
            p1 = __builtin_amdgcn_mfma_f32_32x32x16_bf16(kf1[ks], qr[ks], p1, 0, 0, 0);
        }
        v2u vf0[4][2], vf1[4][2];
#pragma unroll
        for (int ks = 0; ks < 4; ++ks) { const LAS unsigned char* vb = vtb + (16 * ks + 4 * hi) * 2;
            vf0[ks][0] = *(const LAS v2u*)(vb + r32 * VROW); vf0[ks][1] = *(const LAS v2u*)(vb + r32 * VROW + 16);
            vf1[ks][0] = *(const LAS v2u*)(vb + (32 + r32) * VROW); vf1[ks][1] = *(const LAS v2u*)(vb + (32 + r32) * VROW + 16); }
        __builtin_amdgcn_sched_barrier(0);
        const bool diag = (kv0 + 63 >= qrow0);
        if (!SB) {
            if (diag) {
#pragma unroll
                for (int r = 0; r < 16; ++r) { const int kv = kv0 + crow(r, hi); if (kv > qglob) p0[r] = -INFINITY; if (kv + 32 > qglob) p1[r] = -INFINITY; }
            }
            if (FIXREF) {
                float rs = 0.f;
#pragma unroll
                for (int r = 0; r < 16; ++r) { p0[r] = __builtin_amdgcn_exp2f(p0[r]); p1[r] = __builtin_amdgcn_exp2f(p1[r]); rs += p0[r] + p1[r]; }
                l_run += rs;
            } else {
            float rm = fmaxf(p0[0], p1[0]);
#pragma unroll
            for (int r = 1; r < 16; ++r) rm = fmaxf(rm, fmaxf(p0[r], p1[r]));
            rm = fmaxf(rm, __shfl_xor(rm, 32));
            const float m_new = fmaxf(m_run, rm);
            const float f = __builtin_amdgcn_exp2f(m_run - m_new);
            m_run = m_new;
            float rs = 0.f;
#pragma unroll
            for (int r = 0; r < 16; ++r) { p0[r] = __builtin_amdgcn_exp2f(p0[r] - m_new); p1[r] = __builtin_amdgcn_exp2f(p1[r] - m_new); rs += p0[r] + p1[r]; }
            l_run = l_run * f + rs;
            if (__any(f != 1.0f)) {
#pragma unroll
                for (int r = 0; r < 16; ++r) { o0[r] *= f; o1[r] *= f; }
            }
            }
        } else {
            f32x16 L0, L1;
#pragma unroll
            for (int r = 0; r < 16; ++r) {
                const float z0 = p0[r] * 0.125f, z1 = p1[r] * 0.125f;
                const float s0 = fmaxf(z0, 0.f) + __logf(1.0f + __expf(-fabsf(z0))), s1 = fmaxf(z1, 0.f) + __logf(1.0f + __expf(-fabsf(z1)));
                const int kv = kv0 + crow(r, hi);
                const bool v0 = !diag || (kv < qglob), v1 = !diag || (kv + 32 < qglob);
                p0[r] = v0 ? z0 : -INFINITY; p1[r] = v1 ? z1 : -INFINITY;
                L0[r] = v0 ? -s0 : 0.f; L1[r] = v1 ? -s1 : 0.f;
            }
            float gs[8], gp[8], tot[8], suf[8];
#pragma unroll
            for (int g = 0; g < 4; ++g) { gs[g] = (L0[4 * g] + L0[4 * g + 1]) + (L0[4 * g + 2] + L0[4 * g + 3]); gs[4 + g] = (L1[4 * g] + L1[4 * g + 1]) + (L1[4 * g + 2] + L1[4 * g + 3]); }
#pragma unroll
            for (int g = 0; g < 8; ++g) { gp[g] = __shfl_xor(gs[g], 32); tot[g] = gs[g] + gp[g]; }
            suf[7] = 0.f;
#pragma unroll
            for (int g = 6; g >= 0; --g) suf[g] = suf[g + 1] + tot[g + 1];
#pragma unroll
            for (int g = 0; g < 8; ++g) {
                const float E = suf[g] + (hi == 0 ? gp[g] : 0.f) + A;
                if (g < 4) { const float c3 = L0[4 * g + 3] + E, c2 = L0[4 * g + 2] + c3, c1 = L0[4 * g + 1] + c2, c0 = L0[4 * g] + c1;
                    p0[4 * g] = __expf(p0[4 * g] + c0); p0[4 * g + 1] = __expf(p0[4 * g + 1] + c1); p0[4 * g + 2] = __expf(p0[4 * g + 2] + c2); p0[4 * g + 3] = __expf(p0[4 * g + 3] + c3); }
                else { const int q = g - 4; const float c3 = L1[4 * q + 3] + E, c2 = L1[4 * q + 2] + c3, c1 = L1[4 * q + 1] + c2, c0 = L1[4 * q] + c1;
                    p1[4 * q] = __expf(p1[4 * q] + c0); p1[4 * q + 1] = __expf(p1[4 * q + 1] + c1); p1[4 * q + 2] = __expf(p1[4 * q + 2] + c2); p1[4 * q + 3] = __expf(p1[4 * q + 3] + c3); }
            }
            A = A + (suf[0] + tot[0]);
            dead = __all(A < -104.0f);
        }
        bf16x8 pw[4];
        { v4u t;
          t.x = cvtpk(p0[0], p0[1]); t.y = cvtpk(p0[2], p0[3]); t.z = cvtpk(p0[4], p0[5]); t.w = cvtpk(p0[6], p0[7]); pw[0] = __builtin_bit_cast(bf16x8, t);
          t.x = cvtpk(p0[8], p0[9]); t.y = cvtpk(p0[10], p0[11]); t.z = cvtpk(p0[12], p0[13]); t.w = cvtpk(p0[14], p0[15]); pw[1] = __builtin_bit_cast(bf16x8, t);
          t.x = cvtpk(p1[0], p1[1]); t.y = cvtpk(p1[2], p1[3]); t.z = cvtpk(p1[4], p1[5]); t.w = cvtpk(p1[6], p1[7]); pw[2] = __builtin_bit_cast(bf16x8, t);
          t.x = cvtpk(p1[8], p1[9]); t.y = cvtpk(p1[10], p1[11]); t.z = cvtpk(p1[12], p1[13]); t.w = cvtpk(p1[14], p1[15]); pw[3] = __builtin_bit_cast(bf16x8, t); }
#pragma unroll
        for (int ks = 0; ks < 4; ++ks) {
            const v4u a0 = {vf0[ks][0].x, vf0[ks][0].y, vf0[ks][1].x, vf0[ks][1].y}, a1 = {vf1[ks][0].x, vf1[ks][0].y, vf1[ks][1].x, vf1[ks][1].y};
            o0 = __builtin_amdgcn_mfma_f32_32x32x16_bf16(__builtin_bit_cast(bf16x8, a0), pw[ks], o0, 0, 0, 0);
            o1 = __builtin_amdgcn_mfma_f32_32x32x16_bf16(__builtin_bit_cast(bf16x8, a1), pw[ks], o1, 0, 0, 0);
        }
        }
        if (SB && lane == 0) flags[cur * 8 + wid] = dead ? 1 : 0;
        if (more) ATT_STORE(cur ^ 1);
        __syncthreads();
    }
#undef ATT_LOAD
#undef ATT_STORE
    float inv = 1.0f;
    if (!SB) { const float lt = l_run + __shfl_xor(l_run, 32); inv = 1.0f / lt; }
    bf16* orow = Op + (size_t)(qrow0 + r32) * opitch;
#pragma unroll
    for (int g = 0; g < 4; ++g) {
        v2u w0, w1;
        w0.x = cvtpk(o0[4 * g] * inv, o0[4 * g + 1] * inv); w0.y = cvtpk(o0[4 * g + 2] * inv, o0[4 * g + 3] * inv);
        w1.x = cvtpk(o1[4 * g] * inv, o1[4 * g + 1] * inv); w1.y = cvtpk(o1[4 * g + 2] * inv, o1[4 * g + 3] * inv);
        *(v2u*)(orow + 8 * g + 4 * hi) = w0; *(v2u*)(orow + 32 + 8 * g + 4 * hi) = w1;
    }
    __syncthreads();
}
constexpr int NPH = 23;
#ifndef MK_PER_PHASE
#define MK_PER_PHASE 0
#endif
struct Args { const float* in[30]; float* out; unsigned char* ws; int ph_lo, ph_hi, rep, li; };
__device__ const double kInvFreq4[4] = {1.0, 0.5623413251903491, 0.31622776601683794, 0.1778279410038923};

__global__ void __launch_bounds__(NWAVES * 64, 2) fwd(Args args) {
    extern __shared__ __attribute__((aligned(16))) unsigned char lds_raw[];
    LAS unsigned char* lds = (LAS unsigned char*)lds_raw;
    volatile LAS unsigned* MISC = (volatile LAS unsigned*)(lds + MISC_OFF);
    const int tid = threadIdx.x, lane = tid & 63, wave = __builtin_amdgcn_readfirstlane(tid >> 6);
    const int G = gridDim.x, bx = blockIdx.x;
    const int vcu = (G % 8 == 0) ? (bx % 8) * (G / 8) + bx / 8 : bx;
    const int gw = vcu * NWAVES + wave, NGW = G * NWAVES;
    unsigned char* ws = args.ws;
    gu32* ctl = (gu32*)(ws + WS_CTL);
    float* out = args.out;
    for (int u = tid; u < (LDS_BYTES - LDSCTL_OFF) / 4; u += NWAVES * 64) ((LAS unsigned*)(lds + LDSCTL_OFF))[u] = 0u;
    __syncthreads();
    const int rep = args.rep;
    XcdBarrier bar; bar.bar = (unsigned*)(ctl + CW_BAR) + args.li * XCD_BAR_WORDS; bar.x = 0; bar.st = nullptr;
    if (!MK_PER_PHASE) bar = xcd_barrier_post((unsigned*)(ctl + CW_BAR) + args.li * XCD_BAR_WORDS, MISC + 8);
#define GRID_BAR() do { if (!MK_PER_PHASE) xcd_barrier(bar); } while (0)
    const int lo = args.ph_lo, hi_ph = args.ph_hi;
#define IN(k) (lo <= (k) && (k) < hi_ph)
#define BOTH(k) (IN(k) && IN((k) + 1))

    bf16* Win_t = (bf16*)(ws + WS_WIN); bf16* Wqup_t = (bf16*)(ws + WS_WQUP); bf16* Wkvup_t = (bf16*)(ws + WS_WKVUP); bf16* Wout_t = (bf16*)(ws + WS_WOUT);
    bf16* Wdgu_t = (bf16*)(ws + WS_WDGU); bf16* Wddn_t = (bf16*)(ws + WS_WDDN); bf16* Wsin_t = (bf16*)(ws + WS_WSIN); bf16* Wglu_t = (bf16*)(ws + WS_WGLU);
    bf16* Mgu_t = (bf16*)(ws + WS_MGU); bf16* Mdn_t = (bf16*)(ws + WS_MDN);
    bf16* XN = (bf16*)(ws + WS_XN); bf16* Hb = (bf16*)(ws + WS_H); bf16* QRAW = (bf16*)(ws + WS_QRAW); bf16* KVRAW = (bf16*)(ws + WS_KVRAW);
    bf16* QM = (bf16*)(ws + WS_QM); bf16* KM = (bf16*)(ws + WS_KM); bf16* MERGED = (bf16*)(ws + WS_MERGED); bf16* CQ = (bf16*)(ws + WS_CQ); bf16* CKV = (bf16*)(ws + WS_CKV);
    bf16* DACT = (bf16*)(ws + WS_DACT); float* Ub = (float*)(ws + WS_U); float* HEND = (float*)(ws + WS_HEND); bf16* Yb = (bf16*)(ws + WS_Y);
    bf16* XS = (bf16*)(ws + WS_XS); bf16* MACT = (bf16*)(ws + WS_MACT); int* LTOK = (int*)(ws + WS_LTOK); float* LW = (float*)(ws + WS_LW);
    int* STOK = (int*)(ws + WS_STOK); float* SWT = (float*)(ws + WS_SW); int* TILEE = (int*)(ws + WS_TILEE);
    float* ROPE = (float*)(ws + WS_ROPE); float* STAB = (float*)(ws + WS_STAB);

    if (IN(0)) {
        LAS float* scr = (LAS float*)(lds + RING_OFF + wave * 16384);
        constexpr int I_IN = 16 * 61, I_QU = 4 * 24, I_KVU = 2 * 32, I_OUT = 16 * 32, I_DG = 16 * 112, I_DD = 56 * 32, I_SIN = 16 * 16, I_GLU = 8 * 64;
        constexpr int NIT = I_IN + I_QU + I_KVU + I_OUT + 2 * I_DG + I_DD + I_SIN + I_GLU;
        for (int it = gw; it < NIT; it += NGW) {
            int r = it;
            if (r < I_IN) { const int kb = r / 61, nb = r % 61; transpose_item(args.in[2], INC, 64 * kb, 32 * nb, Win_t + (size_t)(32 * nb) * 1024 + 64 * kb, 1024, scr, lane); continue; } r -= I_IN;
            if (r < I_QU) { const int kb = r / 24, nb = r % 24; transpose_item(args.in[4], 768, 64 * kb, 32 * nb, Wqup_t + (size_t)(32 * nb) * 256 + 64 * kb, 256, scr, lane); continue; } r -= I_QU;
            if (r < I_KVU) { const int kb = r / 32, nb = r % 32; transpose_item(args.in[6], 1024, 64 * kb, 32 * nb, Wkvup_t + (size_t)(32 * nb) * 128 + 64 * kb, 128, scr, lane); continue; } r -= I_KVU;
            if (r < I_OUT) { const int kb = r / 32, nb = r % 32; transpose_item(args.in[9], 1024, 64 * kb, 32 * nb, Wout_t + (size_t)(32 * nb) * 1024 + 64 * kb, 1024, scr, lane); continue; } r -= I_OUT;
            if (r < 2 * I_DG) { const int which = r / I_DG, rr = r % I_DG, kb = rr / 112, nb = rr % 112, n0 = 32 * nb; const int drow = 256 * (n0 / 128) + 128 * which + (n0 % 128);
                transpose_item(args.in[11 + which], FF, 64 * kb, n0, Wdgu_t + (size_t)drow * 1024 + 64 * kb, 1024, scr, lane); continue; } r -= 2 * I_DG;
            if (r < I_DD) { const int kb = r / 32, nb = r % 32; transpose_item(args.in[13], 1024, 64 * kb, 32 * nb, Wddn_t + (size_t)(32 * nb) * FF + 64 * kb, FF, scr, lane); continue; } r -= I_DD;
            if (r < I_SIN) { const int kb = r / 16, nb = r % 16; transpose_item(args.in[15], SW, 64 * kb, 32 * nb, Wsin_t + (size_t)(32 * nb) * 1024 + 64 * kb, 1024, scr, lane); continue; } r -= I_SIN;
            { const int kb = r / 64, nb = r % 64, n0 = 32 * nb; const int nn = n0 & 1023; const int drow = 256 * (nn / 128) + 128 * (n0 >> 10) + (nn % 128);
                transpose_item(args.in[24], 2048, 64 * kb, n0, Wglu_t + (size_t)drow * SW + 64 * kb, SW, scr, lane); }
        }
        for (int i = bx * (NWAVES * 64) + tid; i < 96 * 128; i += G * NWAVES * 64) ((v4u*)(Win_t + (size_t)INC * 1024))[i] = (v4u){0u, 0u, 0u, 0u};
        for (int i = bx * (NWAVES * 64) + tid; i < SEQ * 16; i += G * NWAVES * 64) {
            const int t = i >> 4, f = i & 15; double inv = kInvFreq4[f & 3]; const int dec = f >> 2; if (dec >= 1) inv *= 0.1; if (dec >= 2) inv *= 0.1; if (dec >= 3) inv *= 0.1;
            const double rev = (double)t * (double)(float)inv * 0.15915494309189535; const double fr = rev - __builtin_rint(rev);
            ROPE[2 * i] = __builtin_amdgcn_cosf((float)fr); ROPE[2 * i + 1] = __builtin_amdgcn_sinf((float)fr);
        }
        for (int i = bx * (NWAVES * 64) + tid; i < 32 * 64; i += G * NWAVES * 64) {
            const int g = i >> 6, n = i & 63;
            double are = (double)args.in[16][i]; if (are > -1e-4) are = -1e-4; const double aim = (double)args.in[17][i];
            const double dt = exp((double)args.in[18][g]);
            const double mag = exp(are * dt), lre = mag * cos(aim * dt), lim = mag * sin(aim * dt);
            const double den = are * are + aim * aim, nre = lre - 1.0;
            const double cre = (nre * are + lim * aim) / den, cim = (lim * are - nre * aim) / den;
            const double magL = exp(are * dt * CH), lLre = magL * cos(aim * dt * CH), lLim = magL * sin(aim * dt * CH);
            float* tb = STAB + (size_t)g * 36 * 64 + n;
            tb[0 * 64] = (float)lre; tb[1 * 64] = (float)lim; tb[2 * 64] = (float)lLre; tb[3 * 64] = (float)lLim;
            for (int c = 0; c < 16; ++c) { const double bre = (double)args.in[19][(size_t)i * 16 + c], bim = (double)args.in[20][(size_t)i * 16 + c];
                tb[(4 + c) * 64] = (float)(cre * bre - cim * bim); tb[(20 + c) * 64] = (float)(cre * bim + cim * bre); }
        }
        for (int m = gw; m < M; m += NGW) rms_row_to_bf16(args.in[0] + (size_t)m * D, args.in[1], XN + (size_t)m * D, lane);
        if (BOTH(0)) GRID_BAR();
    }
    if (IN(1)) {
        pg8::Gemm g{XN, Win_t, M, INP, D}; pg8::StaticOrder S; S.init(M, INP, G, bx);
        pg8::EpiBf16Plain E{Hb, INP};
        pg8::gemm_phase<pg8::EpiBf16Plain, pg8::StaticOrder, true, true>(lds + RING_OFF, g, S, E);
        if (BOTH(1)) GRID_BAR();
    }
    if (IN(2)) {
        const float* gq = args.in[3]; const float* gkv = args.in[5];
        for (int m = gw; m < M; m += NGW) {
            const bf16* hr = Hb + (size_t)m * INP;
            { const v2u raw = *(const v2u*)(hr + 1536 + 4 * lane); const float a = bflo(raw.x), b = bfhi(raw.x), c = bflo(raw.y), d = bfhi(raw.y);
              const float rstd = 1.0f / sqrtf(wave_sum((a * a + b * b) + (c * c + d * d)) * (1.f / 256.f) + EPS); const f32x4 gg = *(const f32x4*)(gq + 4 * lane);
              v2u o; o.x = pk2(a * rstd * gg.x, b * rstd * gg.y); o.y = pk2(c * rstd * gg.z, d * rstd * gg.w); *(v2u*)(CQ + (size_t)m * 256 + 4 * lane) = o; }
            { const unsigned raw = *(const unsigned*)(hr + 1792 + 2 * lane); const float a = bflo(raw), b = bfhi(raw);
              const float rstd = 1.0f / sqrtf(wave_sum(a * a + b * b) * (1.f / 128.f) + EPS);
              *(unsigned*)(CKV + (size_t)m * 128 + 2 * lane) = pk2(a * rstd * gkv[2 * lane], b * rstd * gkv[2 * lane + 1]); }
        }
        if (BOTH(2)) GRID_BAR();
    }
    if (IN(3)) {
        pg8::Gemm g{CQ, Wqup_t, M, 768, 256}; pg8::StaticOrder S; S.init(M, 768, G, bx);
        pg8::EpiBf16Plain E{QRAW, 768};
        pg8::gemm_phase<pg8::EpiBf16Plain, pg8::StaticOrder, true, true>(lds + RING_OFF, g, S, E);
        if (BOTH(3)) GRID_BAR();
    }
    if (IN(4)) {
        pg8::Gemm g{CKV, Wkvup_t, M, 1024, 128}; pg8::StaticOrder S; S.init(M, 1024, G, bx);
        pg8::EpiBf16Plain E{KVRAW, 1024};
        pg8::gemm_phase<pg8::EpiBf16Plain, pg8::StaticOrder, true, true>(lds + RING_OFF, g, S, E);
        if (BOTH(4)) GRID_BAR();
    }
    if (IN(5)) {
        const float* qg = args.in[7]; const float* kg = args.in[8];
        constexpr float QSCALE = 0.10206207261596575f * 1.4426950408889634f;
        for (int idx = bx * (NWAVES * 64) + tid; idx < M * 8; idx += G * NWAVES * 64) {
            const int m = idx >> 3, h = idx & 7, t = m & (SEQ - 1);
            const f32x4* rp = (const f32x4*)(ROPE + (size_t)t * 32);
            float cs[16], sn[16];
#pragma unroll
            for (int i = 0; i < 8; ++i) { const f32x4 v = rp[i]; cs[2 * i] = v.x; sn[2 * i] = v.y; cs[2 * i + 1] = v.z; sn[2 * i + 1] = v.w; }
#pragma unroll
            for (int which = 0; which < 2; ++which) {
                v4u ch[12];
                if (which == 0) {
                    const v4u* src = (const v4u*)(QRAW + (size_t)m * 768 + h * 96);
#pragma unroll
                    for (int c = 0; c < 12; ++c) ch[c] = src[c];
                } else {
                    const v4u* s1 = (const v4u*)(KVRAW + (size_t)m * 1024 + h * 128); const v4u* s2 = (const v4u*)(Hb + (size_t)m * INP + 1920);
#pragma unroll
                    for (int c = 0; c < 8; ++c) ch[c] = s1[c];
#pragma unroll
                    for (int c = 0; c < 4; ++c) ch[8 + c] = s2[c];
                }
                float ss = 0.f;
#pragma unroll
                for (int c = 0; c < 12; ++c) { const v4u v = ch[c]; const float a0 = bflo(v.x), a1 = bfhi(v.x), a2 = bflo(v.y), a3 = bfhi(v.y), a4 = bflo(v.z), a5 = bfhi(v.z), a6 = bflo(v.w), a7 = bfhi(v.w);
                    ss += ((a0 * a0 + a1 * a1) + (a2 * a2 + a3 * a3)) + ((a4 * a4 + a5 * a5) + (a6 * a6 + a7 * a7)); }
                const float rstd = 1.0f / sqrtf(ss * (1.f / 96.f) + EPS);
                const float osc = which == 0 ? QSCALE : 1.0f;
                const float* gn = which == 0 ? qg : kg;
                bf16* dst = (which == 0 ? QM : KM) + (size_t)m * 768 + h * 96;
#pragma unroll
                for (int c = 0; c < 8; ++c) { const v4u v = ch[c]; float a[8] = {bflo(v.x), bfhi(v.x), bflo(v.y), bfhi(v.y), bflo(v.z), bfhi(v.z), bflo(v.w), bfhi(v.w)};
#pragma unroll
                    for (int e = 0; e < 8; ++e) a[e] = a[e] * rstd * gn[8 * c + e] * osc;
                    v4u o; o.x = pk2(a[0], a[1]); o.y = pk2(a[2], a[3]); o.z = pk2(a[4], a[5]); o.w = pk2(a[6], a[7]); ((v4u*)dst)[c] = o; }
#pragma unroll
                for (int c = 0; c < 2; ++c) { const v4u v1 = ch[8 + c], v2 = ch[10 + c];
                    float a[8] = {bflo(v1.x), bfhi(v1.x), bflo(v1.y), bfhi(v1.y), bflo(v1.z), bfhi(v1.z), bflo(v1.w), bfhi(v1.w)};
                    float b[8] = {bflo(v2.x), bfhi(v2.x), bflo(v2.y), bfhi(v2.y), bflo(v2.z), bfhi(v2.z), bflo(v2.w), bfhi(v2.w)};
                    float ra[8], rb[8];
#pragma unroll
                    for (int e = 0; e < 8; ++e) { const float r1 = a[e] * rstd * gn[64 + 8 * c + e], r2 = b[e] * rstd * gn[80 + 8 * c + e]; const float co = cs[8 * c + e], si = sn[8 * c + e];
                        ra[e] = (r1 * co - r2 * si) * osc; rb[e] = (r2 * co + r1 * si) * osc; }
                    v4u o1, o2; o1.x = pk2(ra[0], ra[1]); o1.y = pk2(ra[2], ra[3]); o1.z = pk2(ra[4], ra[5]); o1.w = pk2(ra[6], ra[7]);
                    o2.x = pk2(rb[0], rb[1]); o2.y = pk2(rb[2], rb[3]); o2.z = pk2(rb[4], rb[5]); o2.w = pk2(rb[6], rb[7]);
                    ((v4u*)dst)[8 + c] = o1; ((v4u*)dst)[10 + c] = o2; }
            }
        }
        if (BOTH(5)) GRID_BAR();
    }
    if (IN(6)) {
        float mq = 0.f, mk = 0.f;
        for (int i = 0; i < 96; ++i) { mq = fmaxf(mq, fabsf(args.in[7][i])); mk = fmaxf(mk, fabsf(args.in[8][i])); }
        const float sref = 9.797958971132712f * 1.4426950408889634f * 1.02f * mq * mk;
        const bool fixref = sref <= 60.0f;
        for (;;) {
            __syncthreads();
            if (tid == 0) MISC[0] = __hip_atomic_fetch_add(ctl + CW_QUEUE + rep, 1u, RLX_AGENT);
            __syncthreads();
            const int idx0 = (int)MISC[0];
            if (idx0 >= 1024) break;
            const int idx = idx0 & 1023;
            const int qb = 31 - (idx >> 5), r = idx & 31, kind = r >> 4, bh = r & 15, b = bh >> 3, h = bh & 7;
            const size_t rb = (size_t)b * SEQ;
#ifdef PROBE_ATT_KIND
            if (rep && kind != PROBE_ATT_KIND) continue;
#endif
            if (kind == 0) {
                if (fixref) attn_unit<96, false, true>(lds, QM + rb * 768 + h * 96, 768, KM + rb * 768 + h * 96, 768, KVRAW + rb * 1024 + h * 128 + 64, 1024, MERGED + rb * 1024 + 512 + h * 64, 1024, qb, tid, wave, lane, -sref);
                else attn_unit<96, false, false>(lds, QM + rb * 768 + h * 96, 768, KM + rb * 768 + h * 96, 768, KVRAW + rb * 1024 + h * 128 + 64, 1024, MERGED + rb * 1024 + 512 + h * 64, 1024, qb, tid, wave, lane, 0.f);
            } else attn_unit<64, true, false>(lds, Hb + rb * INP + h * 64, INP, Hb + rb * INP + 512 + h * 64, INP, Hb + rb * INP + 1024 + h * 64, INP, MERGED + rb * 1024 + h * 64, 1024, qb, tid, wave, lane, 0.f);
        }
        if (BOTH(6)) GRID_BAR();
    }
    if (IN(7)) {
        pg8::Gemm g{MERGED, Wout_t, M, D, D}; pg8::StaticOrder S; S.init(M, D, G, bx);
        pg8::EpiResF32 E{args.in[0], out, D, 1.0f};
        pg8::gemm_phase<pg8::EpiResF32, pg8::StaticOrder, true, true>(lds + RING_OFF, g, S, E);
        if (BOTH(7)) GRID_BAR();
    }
    if (IN(8)) {
        for (int m = gw; m < M; m += NGW) rms_row_to_bf16(out + (size_t)m * D, args.in[10], XN + (size_t)m * D, lane);
        if (BOTH(8)) GRID_BAR();
    }
    if (IN(9)) {
        pg8::Gemm g{XN, Wdgu_t, M, 2 * FF, D}; pg8::StaticOrder S; S.init(M, 2 * FF, G, bx);
        pg8::EpiSwiGLU E{DACT, FF, 28, 0};
        pg8::gemm_phase<pg8::EpiSwiGLU, pg8::StaticOrder, true, true>(lds + RING_OFF, g, S, E);
        if (BOTH(9)) GRID_BAR();
    }
    if (IN(10)) {
        pg8::Gemm g{DACT, Wddn_t, M, D, FF}; pg8::StaticOrder S; S.init(M, D, G, bx);
        pg8::EpiResF32 E{out, out, D, rep ? 0.0f : 1.0f};
        pg8::gemm_phase<pg8::EpiResF32, pg8::StaticOrder, true, true>(lds + RING_OFF, g, S, E);
        if (BOTH(10)) GRID_BAR();
    }
    if (IN(11)) {
        for (int m = gw; m < M; m += NGW) rms_row_to_bf16(out + (size_t)m * D, args.in[14], XN + (size_t)m * D, lane);
        LAS float* scr = (LAS float*)(lds + RING_OFF + wave * 16384);
        constexpr int I_G = 16 * 112, I_GU = NE * 2 * I_G, I_DN = NE * 56 * 32;
        for (int it = gw; it < I_GU + I_DN; it += NGW) {
            if (it < I_GU) { const int e = it / (2 * I_G), r1 = it % (2 * I_G), which = r1 / I_G, rr = r1 % I_G, kb = rr / 112, nb = rr % 112, n0 = 32 * nb;
                const int drow = e * 2 * FF + 256 * (n0 / 128) + 128 * which + (n0 % 128);
                transpose_item(args.in[27 + which] + (size_t)e * D * FF, FF, 64 * kb, n0, Mgu_t + (size_t)drow * 1024 + 64 * kb, 1024, scr, lane); }
            else { const int r = it - I_GU, e = r / (56 * 32), rr = r % (56 * 32), kb = rr / 32, nb = rr % 32, k0 = 64 * kb, p = k0 / FFH;
                transpose_item(args.in[29] + (size_t)e * FF * D, D, k0, 32 * nb, Mdn_t + (size_t)p * (NE * 1024) * FFH + (size_t)(e * 1024 + 32 * nb) * FFH + (k0 - p * FFH), FFH, scr, lane); }
        }
        if (BOTH(11)) GRID_BAR();
    }
    if (IN(12)) {
        pg8::Gemm g{XN, Wsin_t, M, SW, D}; pg8::StaticOrder S; S.init(M, SW, G, bx);
        pg8::EpiResF32 E{nullptr, Ub, SW, 1.0f};
        pg8::gemm_phase<pg8::EpiResF32, pg8::StaticOrder, true, true>(lds + RING_OFF, g, S, E);
        if (BOTH(12)) GRID_BAR();
    }
#define SSM_BFRAGS() \
        bf16x8 bm[8]; \
        _Pragma("unroll") for (int cb = 0; cb < 8; ++cb) { v4u t = {0u, 0u, 0u, 0u}; \
            if (kq < 2) { const float* sp = STAB + (size_t)g * 36 * 64 + (size_t)(((cb >> 2) ? 20 : 4) + 8 * kq) * 64 + 16 * (cb & 3) + cc; \
                t.x = pk2(sp[0], sp[64]); t.y = pk2(sp[128], sp[192]); t.z = pk2(sp[256], sp[320]); t.w = pk2(sp[384], sp[448]); } \
            bm[cb] = __builtin_bit_cast(bf16x8, t); }
#define SSM_BU_BLOCK(tb16) do { \
        v4u at = {0u, 0u, 0u, 0u}; \
        if (kq < 2) { const float* up = Ub + (m0 + (tb16) * 16 + cc) * SW + 16 * g + 8 * kq; const f32x4 u0 = *(const f32x4*)up, u1 = *(const f32x4*)(up + 4); \
            at.x = pk2(u0.x, u0.y); at.y = pk2(u0.z, u0.w); at.z = pk2(u1.x, u1.y); at.w = pk2(u1.z, u1.w); } \
        const bf16x8 af = __builtin_bit_cast(bf16x8, at); \
        f32x4 dd[8];              \
        _Pragma("unroll") for (int cb = 0; cb < 8; ++cb) { const f32x4 z = {0.f, 0.f, 0.f, 0.f}; dd[cb] = __builtin_amdgcn_mfma_f32_16x16x32_bf16(af, bm[cb], z, 0, 0, 0); } \
        __builtin_amdgcn_sched_barrier(0); \
        _Pragma("unroll") for (int cb = 0; cb < 8; ++cb) *(LAS f32x4*)(bu + (16 * cb + cc) * 20 + 4 * kq) = dd[cb]; \
        LDS_WAIT(); asm volatile("" ::: "memory"); } while (0)
    if (IN(13)) {
        LAS float* bu = (LAS float*)(lds + RING_OFF + wave * 16384);
        const int cc = lane & 15, kq = lane >> 4;
        for (int item = gw; item < NB * 32 * NCH; item += NGW) {
            const int b = item / (32 * NCH), g = (item / NCH) % 32, c = item % NCH;
            const float* tb = STAB + (size_t)g * 36 * 64 + lane;
            const float lre = tb[0], lim = tb[64];
            SSM_BFRAGS();
            const size_t m0 = (size_t)b * SEQ + (size_t)c * CH;
            float hr = 0.f, hi2 = 0.f;
            for (int tb16 = 0; tb16 < CH / 16; ++tb16) {
                SSM_BU_BLOCK(tb16);
#pragma unroll
                for (int q = 0; q < 4; ++q) { const f32x4 br = *(const LAS f32x4*)(bu + lane * 20 + 4 * q), bi = *(const LAS f32x4*)(bu + (64 + lane) * 20 + 4 * q);
#pragma unroll
                    for (int e = 0; e < 4; ++e) { const float nr = lre * hr - lim * hi2 + br[e], ni = lre * hi2 + lim * hr + bi[e]; hr = nr; hi2 = ni; } }
                LDS_WAIT(); asm volatile("" ::: "memory");
            }
            *(f32x2*)(HEND + ((size_t)item * 64 + lane) * 2) = (f32x2){hr, hi2};
        }
        if (BOTH(13)) GRID_BAR();
    }
    if (IN(14)) {
        LAS float* bu = (LAS float*)(lds + RING_OFF + wave * 16384);
        LAS unsigned char* hs = lds + RING_OFF + wave * 16384 + 10240;
        const float* cre_p = args.in[21]; const float* cim_p = args.in[22]; const float* dsk_p = args.in[23];
        const int cc = lane & 15, kq = lane >> 4;
        for (int item = gw; item < NB * 32 * NCH; item += NGW) {
            const int b = item / (32 * NCH), g = (item / NCH) % 32, c = item % NCH;
            const float* tb = STAB + (size_t)g * 36 * 64 + lane;
            const float lre = tb[0], lim = tb[64], lLre = tb[128], lLim = tb[192];
            SSM_BFRAGS();
            bf16x8 cm[4];
#pragma unroll
            for (int ks = 0; ks < 4; ++ks) { const int k0 = 32 * ks + 8 * kq; const float* src = (ks < 2 ? cre_p : cim_p) + ((size_t)(g * 16 + cc) * 64 + (k0 & 63)); const float sg = ks < 2 ? 1.f : -1.f;
                const f32x4 a = *(const f32x4*)src, bq = *(const f32x4*)(src + 4);
                v4u t; t.x = pk2(sg * a.x, sg * a.y); t.y = pk2(sg * a.z, sg * a.w); t.z = pk2(sg * bq.x, sg * bq.y); t.w = pk2(sg * bq.z, sg * bq.w); cm[ks] = __builtin_bit_cast(bf16x8, t); }
            const float dsk = dsk_p[16 * g + cc];
            float hr = 0.f, hi2 = 0.f;
            { const float* he = HEND + ((size_t)(item - c) * 64 + lane) * 2;
              int c2 = 0;
              for (; c2 + 8 <= c; c2 += 8) { f32x2 e[8];
#pragma unroll
                  for (int k = 0; k < 8; ++k) e[k] = *(const f32x2*)(he + (size_t)(c2 + k) * 128);
#pragma unroll
                  for (int k = 0; k < 8; ++k) { const float nr = lLre * hr - lLim * hi2 + e[k].x, ni = lLre * hi2 + lLim * hr + e[k].y; hr = nr; hi2 = ni; } }
              for (; c2 < c; ++c2) { const f32x2 e = *(const f32x2*)(he + (size_t)c2 * 128); const float nr = lLre * hr - lLim * hi2 + e.x, ni = lLre * hi2 + lLim * hr + e.y; hr = nr; hi2 = ni; } }
            const size_t m0 = (size_t)b * SEQ + (size_t)c * CH;
            for (int tb16 = 0; tb16 < CH / 16; ++tb16) {
                SSM_BU_BLOCK(tb16);
#pragma unroll
                for (int q = 0; q < 4; ++q) { const f32x4 br = *(const LAS f32x4*)(bu + lane * 20 + 4 * q), bi = *(const LAS f32x4*)(bu + (64 + lane) * 20 + 4 * q);
#pragma unroll
                    for (int e = 0; e < 4; ++e) { const float nr = lre * hr - lim * hi2 + br[e], ni = lre * hi2 + lim * hr + bi[e]; hr = nr; hi2 = ni;
                        const unsigned hp = cvtpk(hr, hi2);
                        *(LAS unsigned short*)(hs + (4 * q + e) * 272 + lane * 2) = (unsigned short)(hp & 0xffffu);
                        *(LAS unsigned short*)(hs + (4 * q + e) * 272 + 128 + lane * 2) = (unsigned short)(hp >> 16); } }
                LDS_WAIT(); asm volatile("" ::: "memory");
                f32x4 acc = {0.f, 0.f, 0.f, 0.f};
#pragma unroll
                for (int ks = 0; ks < 4; ++ks) { const bf16x8 a = *(const LAS bf16x8*)(hs + cc * 272 + (32 * ks + 8 * kq) * 2); acc = __builtin_amdgcn_mfma_f32_16x16x32_bf16(a, cm[ks], acc, 0, 0, 0); }
#pragma unroll
                for (int jj = 0; jj < 4; ++jj) { const size_t mr = m0 + tb16 * 16 + 4 * kq + jj; const float uu = Ub[mr * SW + 16 * g + cc]; const float yv = gelu_tanh(acc[jj] + dsk * uu);
                    Yb[mr * SW + 16 * g + cc] = (bf16)f2bf(yv); }
                LDS_WAIT(); asm volatile("" ::: "memory");
            }
        }
        if (BOTH(14)) GRID_BAR();
    }
#undef SSM_BFRAGS
#undef SSM_BU_BLOCK
    if (IN(15)) {
        pg8::Gemm g{Yb, Wglu_t, M, 2048, SW}; pg8::StaticOrder S; S.init(M, 2048, G, bx);
        pg8::EpiGLU E{out, D, rep ? 0.0f : 1.0f};
        pg8::gemm_phase<pg8::EpiGLU, pg8::StaticOrder, true, true>(lds + RING_OFF, g, S, E);
        if (BOTH(15)) GRID_BAR();
    }
    if (IN(16)) {
        LAS float* rt = (LAS float*)(lds + RING_OFF);
        LAS int* sel_e = (LAS int*)(lds + RING_OFF + 32768);
        LAS float* sel_w = (LAS float*)(lds + RING_OFF + 32768 + 4096);
        LAS int* ebase = (LAS int*)(lds + RING_OFF + 32768 + 8192);
        const float* rw = args.in[26];
        for (int i = tid; i < 2048; i += NWAVES * 64) ((LAS f32x4*)rt)[i] = ((const f32x4*)rw)[i];
        __syncthreads();
        const int tpb = (M + G - 1) / G;
        const int m_lo = vcu * tpb, m_hi = (m_lo + tpb < M) ? m_lo + tpb : M;
        const float* gn = args.in[25];
        for (int m = m_lo + wave; m < m_hi; m += NWAVES) {
            const f32x4* xr = (const f32x4*)(out + (size_t)m * D) + lane; const f32x4* gr = (const f32x4*)gn + lane;
            f32x4 v[4]; float s = 0.f;
#pragma unroll
            for (int j = 0; j < 4; ++j) { v[j] = xr[64 * j]; s += (v[j].x * v[j].x + v[j].y * v[j].y) + (v[j].z * v[j].z + v[j].w * v[j].w); }
            const float rstd = 1.0f / sqrtf(wave_sum(s) * (1.f / D) + EPS);
            float lg[8];
#pragma unroll
            for (int e = 0; e < 8; ++e) lg[e] = 0.f;
            unsigned long long* o8 = (unsigned long long*)(XN + (size_t)m * D) + lane;
#pragma unroll
            for (int j = 0; j < 4; ++j) { const f32x4 g4 = gr[64 * j]; const float y[4] = {v[j].x * rstd * g4.x, v[j].y * rstd * g4.y, v[j].z * rstd * g4.z, v[j].w * rstd * g4.w};
                o8[64 * j] = (unsigned long long)pk2(y[0], y[1]) | ((unsigned long long)pk2(y[2], y[3]) << 32);
#pragma unroll
                for (int q = 0; q < 4; ++q) { const int k = 256 * j + 4 * lane + q; const f32x4 r0 = *(const LAS f32x4*)(rt + k * 8), r1 = *(const LAS f32x4*)(rt + k * 8 + 4);
                    lg[0] += y[q] * r0.x; lg[1] += y[q] * r0.y; lg[2] += y[q] * r0.z; lg[3] += y[q] * r0.w; lg[4] += y[q] * r1.x; lg[5] += y[q] * r1.y; lg[6] += y[q] * r1.z; lg[7] += y[q] * r1.w; } }
#pragma unroll
            for (int e = 0; e < 8; ++e) lg[e] = wave_sum(lg[e]);
            int e0 = 0; float v0 = lg[0];
#pragma unroll
            for (int e = 1; e < 8; ++e) if (lg[e] > v0) { v0 = lg[e]; e0 = e; }
            int e1 = -1; float v1 = -INFINITY;
#pragma unroll
            for (int e = 0; e < 8; ++e) if (e != e0 && lg[e] > v1) { v1 = lg[e]; e1 = e; }
            const float g1 = 1.0f / (1.0f + expf(v0 - v1)), g0 = 1.0f - g1;
            if (lane == 0) { const int tl = m - m_lo; sel_e[2 * tl] = e0; sel_e[2 * tl + 1] = e1; sel_w[2 * tl] = g0; sel_w[2 * tl + 1] = g1; }
        }
        __syncthreads();
        const int ntl = m_hi - m_lo;
        if (tid < 8 && ntl > 0) { int n = 0; for (int i = 0; i < 2 * ntl; ++i) n += (sel_e[i] == tid) ? 1 : 0;
            ebase[tid] = n ? (int)__hip_atomic_fetch_add(ctl + CW_CNT + 64 * (8 * rep + tid), (unsigned)n, RLX_AGENT) : 0; }
        __syncthreads();
        if (tid < 8 && ntl > 0) { int pos = ebase[tid]; for (int i = 0; i < 2 * ntl; ++i) if (sel_e[i] == tid) { LTOK[(size_t)(8 * rep + tid) * M + pos] = m_lo + (i >> 1) + (i & 1) * M; LW[(size_t)(8 * rep + tid) * M + pos] = sel_w[i]; ++pos; } }
        if (BOTH(16)) GRID_BAR();
    }
    if (IN(17)) {
        LAS int* tinfo = (LAS int*)(lds + RING_OFF);
        if (tid == 0) { int acc = 0; for (int e = 0; e < 8; ++e) { const int cnt = (int)__hip_atomic_load(ctl + CW_CNT + 64 * e, RLX_AGENT); const int nt = (cnt + 255) >> 8; tinfo[e] = cnt; tinfo[8 + e] = acc;
                for (int i = 0; i < nt; ++i) tinfo[32 + acc + i] = e; acc += nt; } tinfo[16] = acc; }
        __syncthreads();
        const int nrt = tinfo[16];
        if (bx == 0) { int t2 = tid; asm volatile("" : "+v"(t2)); if (t2 < nrt) TILEE[t2] = tinfo[32 + t2]; if (tid == 0) TILEE[200] = nrt; }
        for (int s = gw; s < nrt * 256; s += NGW) {
            const int e = tinfo[32 + (s >> 8)], idxe = s - tinfo[8 + e] * 256;
            v4u a = {0u, 0u, 0u, 0u}, b2 = {0u, 0u, 0u, 0u}; int tok = -1; float w = 0.f;
            if (idxe < tinfo[e]) { tok = LTOK[(size_t)e * M + idxe]; w = LW[(size_t)e * M + idxe]; const v4u* src = (const v4u*)(XN + (size_t)(tok & (M - 1)) * D); a = src[lane]; b2 = src[64 + lane]; }
            v4u* dst = (v4u*)(XS + (size_t)s * D); dst[lane] = a; dst[64 + lane] = b2;
            if (lane == 0) { STOK[s] = tok; SWT[s] = w; }
        }
        if (BOTH(17)) GRID_BAR();
    }
#define MOE_PASS(PH, P) \
    if (IN(PH)) { const int nrt = __builtin_amdgcn_readfirstlane(TILEE[200]); \
        pg8::Gemm g{XS, Mgu_t, MAXSLOT, NE * 2 * FF, D}; pg8::MoeOrder S{TILEE, nrt, 14, 28, 14 * (P), G, vcu}; \
        pg8::EpiSwiGLU E{MACT, FFH, 28, 14 * (P)}; \
        pg8::gemm_phase<pg8::EpiSwiGLU, pg8::MoeOrder, true, true>(lds + RING_OFF, g, S, E); \
        if (BOTH(PH)) GRID_BAR(); } \
    if (IN((PH) + 1)) { const int nrt = __builtin_amdgcn_readfirstlane(TILEE[200]); \
        pg8::Gemm g{MACT, Mdn_t + (size_t)(P) * (NE * 1024) * FFH, MAXSLOT, NE * 1024, FFH}; pg8::MoeOrder S{TILEE, nrt, 4, 4, 0, G, vcu}; \
        pg8::EpiMoeDown E{out, XN, STOK, SWT, rep ? 0.0f : 1.0f, ((P) == 0 && rep == 0) ? 1 : 0, M}; \
        pg8::gemm_phase<pg8::EpiMoeDown, pg8::MoeOrder, true, true>(lds + RING_OFF, g, S, E); \
        if (BOTH((PH) + 1)) GRID_BAR(); }
    MOE_PASS(18, 0)
    MOE_PASS(20, 1)
#undef MOE_PASS
    if (IN(22)) {
        int t2 = tid; asm volatile("" : "+v"(t2)); const int lane2 = t2 & 63;
        for (int m = gw; m < M; m += NGW) { f32x4* o = (f32x4*)(out + (size_t)m * D) + lane2; const v2u* y = (const v2u*)(XN + (size_t)m * D) + lane2;
#pragma unroll
            for (int j = 0; j < 4; ++j) { const v2u yy = y[64 * j]; f32x4 v = o[64 * j]; v.x += bflo(yy.x); v.y += bfhi(yy.x); v.z += bflo(yy.y); v.w += bfhi(yy.y); o[64 * j] = v; } }
    }
#undef IN
#undef BOTH
#undef GRID_BAR
}

extern "C" void kernel_launch(void* const* d_in, const int* in_sizes, int n_in, void* d_out, int out_size, void* d_ws, size_t ws_size, hipStream_t stream) {
    static int grid = 0;
    if (grid == 0) {
        if (n_in != 30 || in_sizes[0] != M * D || out_size != M * D || ws_size < WS_END) { fprintf(stderr, "kernel_launch: unexpected shapes (n_in %d, in0 %d, out %d, ws %zu < %zu); nothing launched\n", n_in, n_in > 0 ? in_sizes[0] : -1, out_size, ws_size, (size_t)WS_END); grid = -1; return; }
        int dev = 0, cus = 0, per_cu = 0;
        if (hipGetDevice(&dev) != hipSuccess || hipDeviceGetAttribute(&cus, hipDeviceAttributeMultiprocessorCount, dev) != hipSuccess) { grid = -1; return; }
        if (hipFuncSetAttribute((const void*)fwd, hipFuncAttributeMaxDynamicSharedMemorySize, LDS_BYTES) != hipSuccess) { fprintf(stderr, "kernel_launch: hipFuncSetAttribute failed\n"); grid = -1; return; }
        if (hipOccupancyMaxActiveBlocksPerMultiprocessor(&per_cu, (const void*)fwd, NWAVES * 64, LDS_BYTES) != hipSuccess || per_cu < 1) { fprintf(stderr, "kernel_launch: occupancy query reports %d blocks per CU\n", per_cu); (void)hipGetLastError(); grid = -1; return; }
        grid = cus;
    }
    if (grid < 0) return;
    if (hipMemsetAsync((char*)d_ws + WS_CTL, 0, CTL_ZERO_BYTES, stream) != hipSuccess) return;
    Args a{};
    for (int i = 0; i < 30; ++i) a.in[i] = (const float*)d_in[i];
    a.out = (float*)d_out; a.ws = (unsigned char*)d_ws;
#if MK_PER_PHASE
    for (int p = 0; p < NPH; ++p) { a.ph_lo = p; a.ph_hi = p + 1; hipLaunchKernelGGL(fwd, dim3(grid), dim3(NWAVES * 64), LDS_BYTES, stream, a); }
#elif defined(PROBE_LO)
    a.ph_lo = 0; a.ph_hi = PROBE_HI + 1; a.rep = 0; a.li = 0; hipLaunchKernelGGL(fwd, dim3(grid), dim3(NWAVES * 64), LDS_BYTES, stream, a);
    a.ph_lo = PROBE_LO; a.ph_hi = PROBE_HI + 1; a.rep = 1; a.li = 1; hipLaunchKernelGGL(fwd, dim3(grid), dim3(NWAVES * 64), LDS_BYTES, stream, a);
    if (PROBE_HI + 1 < NPH) { a.ph_lo = PROBE_HI + 1; a.ph_hi = NPH; a.rep = 0; a.li = 2; hipLaunchKernelGGL(fwd, dim3(grid), dim3(NWAVES * 64), LDS_BYTES, stream, a); }
#else
    a.ph_lo = 0; a.ph_hi = NPH; hipLaunchKernelGGL(fwd, dim3(grid), dim3(NWAVES * 64), LDS_BYTES, stream, a);
#endif
}
```
